# Optimizing an MI355X kernel written in HIP

```python
import jax, jax.numpy as jnp
from jax import lax
import numpy as np

D_MODEL = 1024
BATCH = 16
SEQ = 2048
DEPTH = 2

N_A_LAYERS = DEPTH // 2
N_B_LAYERS = DEPTH - N_A_LAYERS

D_FF = 2816
MACARON_WEIGHT = 0.5

HG_HEADS = 8
HG_DK = 128
HG_FD = HG_HEADS * HG_DK
HG_DV = D_MODEL // HG_HEADS
HG_CHUNK = 64

ATT_HEADS = 16
ATT_KV_HEADS = 2
ATT_GROUP = ATT_HEADS // ATT_KV_HEADS
ATT_HEAD_DIM = 64
WINDOW = 128
ATT_SCALE = ATT_HEAD_DIM ** -0.5

ROPE_THETA = 500000.0
ROT_DIM = ATT_HEAD_DIM // 4

EPS = 1e-6

kernel_name = "yoco_hgrn2_swa_sink_macaron"


def rms_norm(x, g):
    xf = x.astype(jnp.float32)
    y = xf * lax.rsqrt(jnp.mean(xf * xf, axis=-1, keepdims=True) + EPS)
    return (y * g.astype(jnp.float32)).astype(x.dtype)


def swiglu(h, w_gate_up, w_down):
    gate, up = jnp.split(h @ w_gate_up, 2, axis=-1)
    return (jax.nn.silu(gate) * up) @ w_down


def partial_rope(x, pos):
    half = ROT_DIM // 2
    inv_freq = jnp.power(ROPE_THETA, -jnp.arange(half, dtype=jnp.float32) * (2.0 / ROT_DIM))
    ang = pos.astype(jnp.float32)[:, None] * inv_freq[None, :]
    cos = jnp.cos(ang)[None, :, None, :]
    sin = jnp.sin(ang)[None, :, None, :]
    xf = x.astype(jnp.float32)
    x1 = xf[..., :half]
    x2 = xf[..., half:ROT_DIM]
    out = jnp.concatenate([x1 * cos - x2 * sin, x2 * cos + x1 * sin, xf[..., ROT_DIM:]], axis=-1)
    return out.astype(x.dtype)


def hgrn2_mixer(h, w_in, lower_bound, onorm_g, w_out):
    B, S, _ = h.shape
    n_chunks = S // HG_CHUNK
    proj = h @ w_in
    q, f, i, g = jnp.split(proj, [HG_FD, 2 * HG_FD, 2 * HG_FD + D_MODEL], axis=-1)
    q = jax.nn.silu(q.astype(jnp.float32))
    forget = lower_bound + (1.0 - lower_bound) * jax.nn.sigmoid(f.astype(jnp.float32))
    k = 1.0 - forget
    log_f = jnp.log(forget)

    def to_chunks(t, d):
        return t.reshape(B, n_chunks, HG_CHUNK, HG_HEADS, d).transpose(1, 0, 3, 2, 4)

    qc = to_chunks(q, HG_DK)
    kc = to_chunks(k, HG_DK)
    vc = to_chunks(i.astype(jnp.float32), HG_DV)
    lc = to_chunks(log_f, HG_DK)
    causal = jnp.tril(jnp.ones((HG_CHUNK, HG_CHUNK), dtype=bool))

    def step(state, inp):
        q_t, k_t, v_t, l_t = inp
        b = jnp.cumsum(l_t, axis=-2)
        b_end = b[..., -1:, :]
        q_e = q_t * jnp.exp(b)
        k_e = k_t * jnp.exp(-b)
        k_d = k_t * jnp.exp(b_end - b)
        scores = jnp.einsum('bhtk,bhsk->bhts', q_e, k_e)
        scores = jnp.where(causal, scores, 0.0)
        o = (jnp.einsum('bhtk,bhkv->bhtv', q_e, state)
             + jnp.einsum('bhts,bhsv->bhtv', scores, v_t))
        new_state = (jnp.exp(b_end)[..., 0, :, None] * state
                     + jnp.einsum('bhsk,bhsv->bhkv', k_d, v_t))
        return new_state, o

    state0 = jnp.zeros((B, HG_HEADS, HG_DK, HG_DV), dtype=jnp.float32)
    _, o = lax.scan(step, state0, (qc, kc, vc, lc))
    o = o.transpose(1, 0, 3, 2, 4).reshape(B, S, HG_HEADS, HG_DV)
    gate = jax.nn.silu(g.astype(jnp.float32)).reshape(B, S, HG_HEADS, HG_DV)
    o = rms_norm(o, onorm_g) * gate
    return o.reshape(B, S, D_MODEL).astype(h.dtype) @ w_out


def shared_kv(h, kv_norm_g, kv_w, k_norm_g, pos):
    B, S, _ = h.shape
    hn = rms_norm(h, kv_norm_g)
    k, v = jnp.split(hn @ kv_w, 2, axis=-1)
    k = k.reshape(B, S, ATT_KV_HEADS, ATT_HEAD_DIM)
    k = partial_rope(rms_norm(k, k_norm_g), pos)
    v = v.reshape(B, S, ATT_KV_HEADS, ATT_HEAD_DIM)
    return k, v


def swa_sink_mixer(h, k, v, w_q, q_norm_g, sinks, w_out, pos):
    B, S, _ = h.shape
    n_blocks = S // WINDOW
    q = (h @ w_q).reshape(B, S, ATT_HEADS, ATT_HEAD_DIM)
    q = partial_rope(rms_norm(q, q_norm_g), pos)
    qb = q.reshape(B, n_blocks, WINDOW, ATT_KV_HEADS, ATT_GROUP, ATT_HEAD_DIM).astype(jnp.float32)
    kb = k.reshape(B, n_blocks, WINDOW, ATT_KV_HEADS, ATT_HEAD_DIM).astype(jnp.float32)
    vb = v.reshape(B, n_blocks, WINDOW, ATT_KV_HEADS, ATT_HEAD_DIM).astype(jnp.float32)
    pad = jnp.zeros_like(kb[:, :1])
    k_band = jnp.concatenate([jnp.concatenate([pad, kb[:, :-1]], axis=1), kb], axis=2)
    v_band = jnp.concatenate([jnp.concatenate([pad, vb[:, :-1]], axis=1), vb], axis=2)
    scores = jnp.einsum('bnqkgd,bnskd->bnkgqs', qb, k_band) * ATT_SCALE
    q_pos = jnp.arange(S).reshape(n_blocks, WINDOW)[:, :, None]
    k_pos = (jnp.arange(n_blocks)[:, None] * WINDOW - WINDOW + jnp.arange(2 * WINDOW)[None, :])[:, None, :]
    delta = q_pos - k_pos
    allowed = (delta >= 0) & (delta < WINDOW) & (k_pos >= 0)
    scores = jnp.where(allowed[None, :, None, None], scores, -jnp.inf)
    sink = jnp.broadcast_to(
        sinks.astype(jnp.float32).reshape(ATT_KV_HEADS, ATT_GROUP)[None, None, :, :, None, None],
        scores.shape[:-1] + (1,))
    probs = jax.nn.softmax(jnp.concatenate([scores, sink], axis=-1), axis=-1)[..., :-1]
    o = jnp.einsum('bnkgqs,bnskd->bnqkgd', probs, v_band)
    o = o.reshape(B, S, ATT_HEADS * ATT_HEAD_DIM).astype(h.dtype)
    return o @ w_out


def setup_inputs(seed: int = 0) -> dict:
    key = jax.random.key(seed)
    ks = jax.random.split(key, 16)
    f32 = jnp.float32

    def w(k, shape, fan_in):
        return jax.random.normal(k, shape, f32) * (fan_in ** -0.5)

    def gain(k, shape):
        return 1.0 + 0.01 * jax.random.normal(k, shape, f32)

    return {
        "x": jax.random.normal(ks[0], (BATCH, SEQ, D_MODEL), f32),
        "ffn_norm_g": gain(ks[1], (DEPTH, 2, D_MODEL)),
        "ffn_w_gate_up": w(ks[2], (DEPTH, 2, D_MODEL, 2 * D_FF), D_MODEL),
        "ffn_w_down": w(ks[3], (DEPTH, 2, D_FF, D_MODEL), D_FF),
        "mix_norm_g": gain(ks[4], (DEPTH, D_MODEL)),
        "hgrn_w_in": w(ks[5], (N_A_LAYERS, D_MODEL, 2 * HG_FD + 2 * D_MODEL), D_MODEL),
        "hgrn_lb_logits": 0.1 * jax.random.normal(ks[6], (N_A_LAYERS + 1, HG_FD), f32),
        "hgrn_onorm_g": gain(ks[7], (N_A_LAYERS, HG_DV)),
        "hgrn_w_out": w(ks[8], (N_A_LAYERS, D_MODEL, D_MODEL), D_MODEL),
        "kv_norm_g": gain(ks[9], (D_MODEL,)),
        "kv_w": w(ks[10], (D_MODEL, 2 * ATT_KV_HEADS * ATT_HEAD_DIM), D_MODEL),
        "k_norm_g": gain(ks[11], (ATT_HEAD_DIM,)),
        "attn_w_q": w(ks[12], (N_B_LAYERS, D_MODEL, ATT_HEADS * ATT_HEAD_DIM), D_MODEL),
        "q_norm_g": gain(ks[13], (N_B_LAYERS, ATT_HEAD_DIM)),
        "attn_sinks": jax.random.normal(ks[14], (N_B_LAYERS, ATT_HEADS), f32),
        "attn_w_out": w(ks[15], (N_B_LAYERS, ATT_HEADS * ATT_HEAD_DIM, D_MODEL), ATT_HEADS * ATT_HEAD_DIM),
    }


def reference(x, ffn_norm_g, ffn_w_gate_up, ffn_w_down, mix_norm_g, hgrn_w_in, hgrn_lb_logits,
              hgrn_onorm_g, hgrn_w_out, kv_norm_g, kv_w, k_norm_g, attn_w_q, q_norm_g,
              attn_sinks, attn_w_out):
    pos = jnp.arange(x.shape[1])
    lower_bounds = jnp.cumsum(jax.nn.softmax(hgrn_lb_logits.astype(jnp.float32), axis=0), axis=0)
    h = x
    k_sh = None
    v_sh = None
    for layer in range(DEPTH):
        h = h + MACARON_WEIGHT * swiglu(rms_norm(h, ffn_norm_g[layer, 0]),
                                        ffn_w_gate_up[layer, 0], ffn_w_down[layer, 0])
        hn = rms_norm(h, mix_norm_g[layer])
        if layer < N_A_LAYERS:
            a = layer
            h = h + hgrn2_mixer(hn, hgrn_w_in[a], lower_bounds[a], hgrn_onorm_g[a], hgrn_w_out[a])
        else:
            b = layer - N_A_LAYERS
            h = h + swa_sink_mixer(hn, k_sh, v_sh, attn_w_q[b], q_norm_g[b], attn_sinks[b],
                                   attn_w_out[b], pos)
        h = h + MACARON_WEIGHT * swiglu(rms_norm(h, ffn_norm_g[layer, 1]),
                                        ffn_w_gate_up[layer, 1], ffn_w_down[layer, 1])
        if layer == N_A_LAYERS - 1:
            k_sh, v_sh = shared_kv(h, kv_norm_g, kv_w, k_norm_g, pos)
    return h
```

```cpp
#include <hip/hip_runtime.h>
#include <hip/hip_cooperative_groups.h>
#include <cstdio>
#include <cstdint>
namespace cg = cooperative_groups;
namespace pg8 {
#define PG8_LAS __attribute__((address_space(3)))
typedef unsigned short bf16_t;
typedef short bf16x8 __attribute__((ext_vector_type(8)));
typedef float f32x4 __attribute__((ext_vector_type(4)));
typedef unsigned u32x4 __attribute__((ext_vector_type(4)));
constexpr int BM = 256, BK = 64, HALF = 128, HTB = HALF * BK * 2  , STAGE_BYTES = 8 * HTB, NXCD = 8, WGM = 8;

__host__ __device__ __forceinline__ int lds_byte(int r, int c) { const int st = (r >> 4) * 2 + (c >> 5), rr = r & 15, cc = c & 31, ob = rr * 64 + cc * 2; return st * 1024 + (ob ^ (((ob >> 9) & 1) << 5)); }
__host__ __device__ __forceinline__ void stage_rc(int b, int& R, int& C) { const int st = b / 1024, sb = b % 1024, swz = sb ^ (((sb >> 9) & 1) << 5); R = (st >> 1) * 16 + swz / 64; C = (st & 1) * 32 + (swz % 64) / 2; }
__host__ __device__ __forceinline__ int perm32(int rho) { const int n = rho >> 4, i = rho & 15; return 8 * (i >> 2) + 4 * n + (i & 3); }

struct Unit { int pm, pn; };
struct Gemm { const bf16_t* A; const bf16_t* Bt; int M, N, K; };

struct StaticOrder {
    int nM, nN, nwg, G, c;
    __host__ __device__ void init(int M, int N, int G_, int c_) { nM = M / BM; nN = N / BM; nwg = nM * nN; G = G_; c = c_; }
    __host__ __device__ bool next(int i, Unit& u) const {
        const long L = (long)i * G + c; if (L >= nwg) return false;
        int wgid = (int)L; { const int q = nwg / NXCD, r = nwg % NXCD, xcd = wgid % NXCD, off = wgid / NXCD; wgid = (xcd < r ? xcd * (q + 1) : r * (q + 1) + (xcd - r) * q) + off; }
        const int nig = WGM * nN, gid = wgid / nig, fm = gid * WGM, gsz = (nM - fm) < WGM ? (nM - fm) : WGM;
        u.pm = fm + ((wgid % nig) % gsz); u.pn = (wgid % nig) / gsz; return true;
    }
    __device__ __forceinline__ void a_ready(const Unit&) const {}
    __device__ __forceinline__ void done(const Unit&) const {}
};

__device__ __forceinline__ unsigned cvt_pk_bf16(float lo, float hi) { unsigned r; asm volatile("v_cvt_pk_bf16_f32 %0, %1, %2" : "=v"(r) : "v"(lo), "v"(hi)); return r; }
typedef float f32x2 __attribute__((ext_vector_type(2)));
__device__ __forceinline__ float fast_rcp(float x) { return __builtin_amdgcn_rcpf(x); }
__device__ __forceinline__ float silu_f(float x) { return x * fast_rcp(1.0f + __expf(-x)); }
__device__ __forceinline__ float sigmoid_f(float x) { return fast_rcp(1.0f + __expf(-x)); }
__device__ __forceinline__ float row_rstd(const float* ssq, int row) {
    const f32x4* p = (const f32x4*)(ssq + (size_t)row * 16);
    const f32x4 a = p[0], b = p[1], c = p[2], d = p[3];
    const float s = (((a[0] + a[1]) + (a[2] + a[3])) + ((b[0] + b[1]) + (b[2] + b[3]))) + (((c[0] + c[1]) + (c[2] + c[3])) + ((d[0] + d[1]) + (d[2] + d[3])));
    return 1.0f / sqrtf(s * (1.0f / 1024.0f) + 1e-6f);
}
struct EpiSwiGLU {
    static constexpr bool PERM = true, AFTER_DRAIN = false;
    bf16_t* O; const float* ssq;
    __device__ __forceinline__ void operator()(const f32x4 (&acc)[2][2][4][2], const Unit& u, int wr, int wc, int fr, int fq) const {
        const int row0 = u.pm * BM + wr * 64 + fr, col0 = u.pn * 128 + wc * 32 + 8 * fq;
#pragma unroll
        for (int ai = 0; ai < 2; ++ai)
#pragma unroll
            for (int m = 0; m < 4; ++m) {
                const int row = row0 + ai * HALF + m * 16; const float rs = row_rstd(ssq, row);
                float o[8];
#pragma unroll
                for (int n = 0; n < 2; ++n)
#pragma unroll
                    for (int e = 0; e < 4; ++e) { const float g = acc[ai][0][m][n][e] * rs, up = acc[ai][1][m][n][e] * rs; o[4 * n + e] = silu_f(g) * up; }
                u32x4 w; w.x = cvt_pk_bf16(o[0], o[1]); w.y = cvt_pk_bf16(o[2], o[3]); w.z = cvt_pk_bf16(o[4], o[5]); w.w = cvt_pk_bf16(o[6], o[7]);
                *(u32x4*)(O + (size_t)row * 2816 + col0) = w;
            }
    }
};
struct EpiResid {
    static constexpr bool PERM = false, AFTER_DRAIN = false;
    const float* base; float* out; bf16_t* hb; float* ssq; float scale; int stats;
    __device__ __forceinline__ void operator()(const f32x4 (&acc)[2][2][4][2], const Unit& u, int wr, int wc, int fr, int fq) const {
        typedef unsigned u32x2v __attribute__((ext_vector_type(2)));
        const int row0 = u.pm * BM + wr * 64 + fr, col0 = u.pn * BM + wc * 32 + 4 * fq;
#pragma unroll
        for (int ai = 0; ai < 2; ++ai)
#pragma unroll
            for (int m = 0; m < 4; ++m) {
                const int row = row0 + ai * HALF + m * 16; const size_t off = (size_t)row * 1024 + col0; float ss = 0.f;
#pragma unroll
                for (int bj = 0; bj < 2; ++bj)
#pragma unroll
                    for (int n = 0; n < 2; ++n) {
                        const f32x4 bs = *(const f32x4*)(base + off + bj * HALF + n * 16);
                        const f32x4 o = bs + acc[ai][bj][m][n] * scale;
                        *(f32x4*)(out + off + bj * HALF + n * 16) = o;
                        if (stats) { u32x2v w; w.x = cvt_pk_bf16(o[0], o[1]); w.y = cvt_pk_bf16(o[2], o[3]); *(u32x2v*)(hb + off + bj * HALF + n * 16) = w;
                            ss += (o[0] * o[0] + o[1] * o[1]) + (o[2] * o[2] + o[3] * o[3]); }
                    }
                if (stats) { ss += __shfl_xor(ss, 16); ss += __shfl_xor(ss, 32); if (fq == 0) ssq[(size_t)row * 16 + u.pn * 4 + wc] = ss; }
            }
    }
};
struct EpiHgrnIn {
    static constexpr bool PERM = true, AFTER_DRAIN = false;
    bf16_t* qb; float* logf; long off_v; long off_g; const float* lbv; const float* ssq;
    __device__ __forceinline__ void operator()(const f32x4 (&acc)[2][2][4][2], const Unit& u, int wr, int wc, int fr, int fq) const {
        const int region = u.pn >> 2; const int row0 = u.pm * BM + wr * 64 + fr, col0 = (u.pn & 3) * BM + wc * 32 + 8 * fq;
        f32x4 lb[2][2];
        if (region == 1) {
#pragma unroll
            for (int bj = 0; bj < 2; ++bj)
#pragma unroll
                for (int n = 0; n < 2; ++n) lb[bj][n] = *(const f32x4*)(lbv + col0 + bj * HALF + 4 * n);
        }
#pragma unroll
        for (int ai = 0; ai < 2; ++ai)
#pragma unroll
            for (int m = 0; m < 4; ++m) {
                const int row = row0 + ai * HALF + m * 16; const float rs = row_rstd(ssq, row); const size_t off = (size_t)row * 1024 + col0;
#pragma unroll
                for (int bj = 0; bj < 2; ++bj) {
                    f32x4 v0 = acc[ai][bj][m][0] * rs, v1 = acc[ai][bj][m][1] * rs;
                    if (region == 1) {
#pragma unroll
                        for (int e = 0; e < 4; ++e) { v0[e] = __logf(lb[bj][0][e] + (1.0f - lb[bj][0][e]) * sigmoid_f(v0[e])); v1[e] = __logf(lb[bj][1][e] + (1.0f - lb[bj][1][e]) * sigmoid_f(v1[e])); }
                        *(f32x4*)(logf + off + bj * HALF) = v0; *(f32x4*)(logf + off + bj * HALF + 4) = v1;
                    } else {
                        if (region != 2) {
#pragma unroll
                            for (int e = 0; e < 4; ++e) { v0[e] = silu_f(v0[e]); v1[e] = silu_f(v1[e]); }
                        }
                        bf16_t* dst = qb + (region == 0 ? 0l : (region == 2 ? off_v : off_g));
                        u32x4 w; w.x = cvt_pk_bf16(v0[0], v0[1]); w.y = cvt_pk_bf16(v0[2], v0[3]); w.z = cvt_pk_bf16(v1[0], v1[1]); w.w = cvt_pk_bf16(v1[2], v1[3]);
                        *(u32x4*)(dst + off + bj * HALF) = w;
                    }
                }
            }
    }
};
template <bool IS_Q> struct EpiHead {
    static constexpr bool PERM = true, AFTER_DRAIN = false;
    bf16_t* O; long off2; const float* gain; const float* rope; const float* ssq; float oscale;
    __device__ __forceinline__ void operator()(const f32x4 (&acc)[2][2][4][2], const Unit& u, int wr, int wc, int fr, int fq) const {
        const int row0 = u.pm * BM + wr * 64 + fr;
        const bool normed = IS_Q || wc < 2;
        f32x4 gn[2][2];
#pragma unroll
        for (int bj = 0; bj < 2; ++bj)
#pragma unroll
            for (int n = 0; n < 2; ++n) gn[bj][n] = *(const f32x4*)(gain + bj * 32 + 8 * fq + 4 * n);
        bf16_t* dst; int ldo, cbase;
        if (IS_Q) { dst = O; ldo = 1024; cbase = (u.pn * 4 + wc) * 64; } else { dst = O + (wc < 2 ? 0l : off2); ldo = 128; cbase = (wc & 1) * 64; }
#pragma unroll
        for (int ai = 0; ai < 2; ++ai)
#pragma unroll
            for (int m = 0; m < 4; ++m) {
                const int row = row0 + ai * HALF + m * 16; const float rs = row_rstd(ssq, row);
                f32x4 v[2][2]; float ss = 0.f;
#pragma unroll
                for (int bj = 0; bj < 2; ++bj)
#pragma unroll
                    for (int n = 0; n < 2; ++n) { v[bj][n] = acc[ai][bj][m][n] * rs; ss += (v[bj][n][0] * v[bj][n][0] + v[bj][n][1] * v[bj][n][1]) + (v[bj][n][2] * v[bj][n][2] + v[bj][n][3] * v[bj][n][3]); }
                ss += __shfl_xor(ss, 16); ss += __shfl_xor(ss, 32);
                if (normed) {
                    const float r = 1.0f / sqrtf(ss * (1.0f / 64.0f) + 1e-6f);
#pragma unroll
                    for (int bj = 0; bj < 2; ++bj)
#pragma unroll
                        for (int n = 0; n < 2; ++n) v[bj][n] = v[bj][n] * r * gn[bj][n];
                }
                f32x4 p0, p1;
#pragma unroll
                for (int e = 0; e < 4; ++e) { p0[e] = __shfl_xor(v[0][0][e], 16); p1[e] = __shfl_xor(v[0][1][e], 16); }
                if (normed && fq < 2) {
                    const f32x4* cs = (const f32x4*)(rope + (size_t)(row & 2047) * 16);
                    const f32x4 c0 = cs[0], c1 = cs[1], c2 = cs[2], c3 = cs[3];
                    const float sg = fq == 0 ? -1.0f : 1.0f;
                    v[0][0][0] = v[0][0][0] * c0[0] + sg * p0[0] * c0[1]; v[0][0][1] = v[0][0][1] * c0[2] + sg * p0[1] * c0[3];
                    v[0][0][2] = v[0][0][2] * c1[0] + sg * p0[2] * c1[1]; v[0][0][3] = v[0][0][3] * c1[2] + sg * p0[3] * c1[3];
                    v[0][1][0] = v[0][1][0] * c2[0] + sg * p1[0] * c2[1]; v[0][1][1] = v[0][1][1] * c2[2] + sg * p1[1] * c2[3];
                    v[0][1][2] = v[0][1][2] * c3[0] + sg * p1[2] * c3[1]; v[0][1][3] = v[0][1][3] * c3[2] + sg * p1[3] * c3[3];
                }
#pragma unroll
                for (int bj = 0; bj < 2; ++bj) {
                    const f32x4 a = v[bj][0] * oscale, b = v[bj][1] * oscale;
                    u32x4 w; w.x = cvt_pk_bf16(a[0], a[1]); w.y = cvt_pk_bf16(a[2], a[3]); w.z = cvt_pk_bf16(b[0], b[1]); w.w = cvt_pk_bf16(b[2], b[3]);
                    *(u32x4*)(dst + (size_t)row * ldo + cbase + bj * 32 + 8 * fq) = w;
                }
            }
    }
};

template <class Epi, class Sched, bool ALIGN_EPI = false, bool SP2 = false>
__device__ __forceinline__ void gemm_phase(PG8_LAS unsigned char* lds, const Gemm g, const Sched& S, const Epi& E) {
    const int tid = threadIdx.x, wid = __builtin_amdgcn_readfirstlane(tid >> 6), lane = tid & 63, wr = wid >> 2, wc = wid & 3, fr = lane & 15, fq = lane >> 4;
    const int K = g.K, nt = K / BK;
    unsigned voffA[2], voffB[2];
#pragma unroll
    for (int i = 0; i < 2; ++i) { int R, C; stage_rc(tid * 16 + i * 8192, R, C); const int Rb = Epi::PERM ? ((R & ~31) + perm32(R & 31)) : R;
        voffA[i] = (unsigned)(R * K + C) * 2u; voffB[i] = (unsigned)(Rb * K + C) * 2u; }
    const size_t kstep = (size_t)(BK * 2);
    const size_t hstep = (size_t)HALF * K * 2;
    const size_t tstep = 2 * hstep;
    const unsigned ldsw = (unsigned)wid * 1024u;
    const int aoff = lds_byte(wr * 64 + fr, fq * 8), boff = lds_byte(wc * 32 + fr, fq * 8);
#define PG8_SA(b, h) (((b) * 2 + (h)) * HTB)
#define PG8_SB(b, h) ((4 + (b) * 2 + (h)) * HTB)
#define PG8_STAGE(bufoff, gbase, voff) do { _Pragma("unroll") for (int _i = 0; _i < 2; ++_i) \
        __builtin_amdgcn_global_load_lds((const unsigned*)((const char*)(gbase) + (voff)[_i]), (PG8_LAS unsigned*)(lds + (bufoff) + ldsw + _i * 8192), 16, 0, 0); } while (0)
#define PG8_LDA(dst, b, h) do { _Pragma("unroll") for (int m = 0; m < 4; ++m) _Pragma("unroll") for (int k = 0; k < 2; ++k) dst[m][k] = *(const PG8_LAS bf16x8*)(lds + PG8_SA(b, h) + aoff + m * 2048 + k * 1024); } while (0)
#define PG8_LDB(dst, b, h) do { _Pragma("unroll") for (int n = 0; n < 2; ++n) _Pragma("unroll") for (int k = 0; k < 2; ++k) dst[n][k] = *(const PG8_LAS bf16x8*)(lds + PG8_SB(b, h) + boff + n * 2048 + k * 1024); } while (0)
#define PG8_MMA(ai, bj, At, Bt) do { __builtin_amdgcn_s_setprio(1); _Pragma("unroll") for (int m = 0; m < 4; ++m) _Pragma("unroll") for (int n = 0; n < 2; ++n) _Pragma("unroll") for (int k = 0; k < 2; ++k) \
        acc[ai][bj][m][n] = __builtin_amdgcn_mfma_f32_16x16x32_bf16(Bt[n][k], At[m][k], acc[ai][bj][m][n], 0, 0, 0); __builtin_amdgcn_s_setprio(0); } while (0)
#define PG8_WAIT_V(n) asm volatile("s_waitcnt vmcnt(" #n ")" ::: "memory")
#define PG8_WAIT_L(n) asm volatile("s_waitcnt lgkmcnt(" #n ")" ::: "memory")
#define PG8_BAR __builtin_amdgcn_s_barrier()
#define PG8_SCHED __builtin_amdgcn_sched_barrier(0)
    Unit cur, nxt; int ui = 0;
    if (!S.next(0, cur)) return;
    f32x4 acc[2][2][4][2];
#pragma unroll
    for (int a = 0; a < 2; ++a)
#pragma unroll
        for (int b = 0; b < 2; ++b)
#pragma unroll
            for (int m = 0; m < 4; ++m)
#pragma unroll
                for (int n = 0; n < 2; ++n) acc[a][b][m][n] = (f32x4){0.f, 0.f, 0.f, 0.f};
    bf16x8 At[4][2], B0[2][2], B1[2][2];
    const char* cA = (const char*)g.A + (size_t)cur.pm * tstep; const char* cB = (const char*)g.Bt + (size_t)cur.pn * tstep;
    S.a_ready(cur);
    if constexpr (SP2) {
        PG8_STAGE(PG8_SB(0, 0), cB, voffB); PG8_STAGE(PG8_SB(0, 1), cB + hstep, voffB); PG8_STAGE(PG8_SA(0, 0), cA, voffA); PG8_STAGE(PG8_SA(0, 1), cA + hstep, voffA);
        if (wr == 1) PG8_BAR;
        PG8_WAIT_V(2); PG8_BAR;
        PG8_STAGE(PG8_SB(1, 0), cB + kstep, voffB); PG8_STAGE(PG8_SA(1, 0), cA + kstep, voffA); PG8_STAGE(PG8_SB(1, 1), cB + hstep + kstep, voffB);
        PG8_WAIT_V(6); PG8_BAR;
    } else {
        PG8_STAGE(PG8_SB(0, 0), cB, voffB); PG8_STAGE(PG8_SA(0, 0), cA, voffA); PG8_STAGE(PG8_SB(0, 1), cB + hstep, voffB); PG8_STAGE(PG8_SA(0, 1), cA + hstep, voffA);
        if (wr == 1) PG8_BAR;
        PG8_WAIT_V(4); PG8_BAR;
        PG8_STAGE(PG8_SB(1, 0), cB + kstep, voffB); PG8_STAGE(PG8_SA(1, 0), cA + kstep, voffA); PG8_STAGE(PG8_SB(1, 1), cB + hstep + kstep, voffB);
        PG8_WAIT_V(6); PG8_BAR;
    }
    for (;;) {
        const bool has_next = S.next(ui + 1, nxt);
        const char* nA = has_next ? (const char*)g.A + (size_t)nxt.pm * tstep : cA; const char* nB = has_next ? (const char*)g.Bt + (size_t)nxt.pn * tstep : cB;
        for (int t = 0; t < nt; t += 2) {
            const bool last = (t == nt - 2);
            const char* a1 = cA + (size_t)(t + 1) * kstep;
            const char* a2 = last ? nA : cA + (size_t)(t + 2) * kstep; const char* b2 = last ? nB : cB + (size_t)(t + 2) * kstep;
            const char* a3 = a2 + kstep; const char* b3 = b2 + kstep;
            if (last && has_next) S.a_ready(nxt);
            if constexpr (SP2) {
            PG8_LDB(B0, 0, 0); PG8_LDB(B1, 0, 1); PG8_SCHED; PG8_LDA(At, 0, 0); PG8_STAGE(PG8_SA(1, 1), a1 + hstep, voffA);
            PG8_WAIT_V(8); PG8_WAIT_L(0); PG8_BAR; PG8_MMA(0, 0, At, B0); PG8_MMA(0, 1, At, B1); PG8_BAR; PG8_SCHED;
            PG8_LDA(At, 0, 1); PG8_STAGE(PG8_SB(0, 0), b2, voffB); PG8_STAGE(PG8_SB(0, 1), b2 + hstep, voffB); PG8_STAGE(PG8_SA(0, 0), a2, voffA);
            PG8_WAIT_V(8); PG8_WAIT_L(0); PG8_BAR; PG8_MMA(1, 0, At, B0); PG8_MMA(1, 1, At, B1); PG8_BAR; PG8_SCHED;
            PG8_LDB(B0, 1, 0); PG8_LDB(B1, 1, 1); PG8_SCHED; PG8_LDA(At, 1, 0); PG8_STAGE(PG8_SA(0, 1), a2 + hstep, voffA);
            PG8_WAIT_V(8); PG8_WAIT_L(0); PG8_BAR; PG8_MMA(0, 0, At, B0); PG8_MMA(0, 1, At, B1); PG8_BAR; PG8_SCHED;
            PG8_LDA(At, 1, 1); PG8_STAGE(PG8_SB(1, 0), b3, voffB); PG8_STAGE(PG8_SB(1, 1), b3 + hstep, voffB); PG8_STAGE(PG8_SA(1, 0), a3, voffA);
            PG8_WAIT_V(8); PG8_WAIT_L(0); PG8_BAR; PG8_MMA(1, 0, At, B0); PG8_MMA(1, 1, At, B1); PG8_BAR; PG8_SCHED;
            } else {
            PG8_LDB(B0, 0, 0); PG8_SCHED; PG8_LDA(At, 0, 0); PG8_STAGE(PG8_SA(1, 1), a1 + hstep, voffA);
            PG8_WAIT_L(8); PG8_BAR; PG8_WAIT_L(0); PG8_MMA(0, 0, At, B0); PG8_BAR; PG8_SCHED;
            PG8_LDB(B1, 0, 1); PG8_STAGE(PG8_SB(0, 0), b2, voffB);
            PG8_BAR; PG8_WAIT_L(0); PG8_MMA(0, 1, At, B1); PG8_BAR;
            PG8_LDA(At, 0, 1); PG8_STAGE(PG8_SA(0, 0), a2, voffA);
            PG8_BAR; PG8_WAIT_L(0); PG8_MMA(1, 0, At, B0); PG8_BAR; PG8_SCHED;
            PG8_STAGE(PG8_SB(0, 1), b2 + hstep, voffB);
            PG8_WAIT_V(6); PG8_BAR; PG8_MMA(1, 1, At, B1); PG8_BAR;
            PG8_LDB(B0, 1, 0); PG8_SCHED; PG8_LDA(At, 1, 0); PG8_STAGE(PG8_SA(0, 1), a2 + hstep, voffA);
            PG8_WAIT_L(8); PG8_BAR; PG8_WAIT_L(0); PG8_MMA(0, 0, At, B0); PG8_BAR; PG8_SCHED;
            PG8_LDB(B1, 1, 1); PG8_STAGE(PG8_SB(1, 0), b3, voffB);
            PG8_BAR; PG8_WAIT_L(0); PG8_MMA(0, 1, At, B1); PG8_BAR;
            PG8_LDA(At, 1, 1); PG8_STAGE(PG8_SA(1, 0), a3, voffA);
            PG8_BAR; PG8_WAIT_L(0); PG8_MMA(1, 0, At, B0); PG8_BAR; PG8_SCHED;
            PG8_STAGE(PG8_SB(1, 1), b3 + hstep, voffB);
            PG8_WAIT_V(6); PG8_BAR; PG8_MMA(1, 1, At, B1); PG8_BAR;
            }
        }
        if constexpr (ALIGN_EPI) { if (wr == 0) PG8_BAR; }
        if constexpr (!Epi::AFTER_DRAIN) { E(acc, cur, wr, wc, fr, fq); S.done(cur); }
        if (!has_next) break;
#pragma unroll
        for (int a = 0; a < 2; ++a)
#pragma unroll
            for (int b = 0; b < 2; ++b)
#pragma unroll
                for (int m = 0; m < 4; ++m)
#pragma unroll
                    for (int n = 0; n < 2; ++n) acc[a][b][m][n] = (f32x4){0.f, 0.f, 0.f, 0.f};
        cur = nxt; cA = nA; cB = nB; ++ui;
        if constexpr (ALIGN_EPI) { if (wr == 1) PG8_BAR; }
    }
    PG8_WAIT_V(0);
    if constexpr (!ALIGN_EPI) { if (wr == 0) PG8_BAR; }
    PG8_BAR;
    if constexpr (Epi::AFTER_DRAIN) { E.fused(acc, cur, wr, wc, fr, fq, lds, wid, lane); S.done(cur); }
#undef PG8_SA
#undef PG8_SB
#undef PG8_STAGE
#undef PG8_LDA
#undef PG8_LDB
#undef PG8_MMA
#undef PG8_WAIT_V
#undef PG8_WAIT_L
#undef PG8_BAR
#undef PG8_SCHED
}
}

constexpr int NWAVES = 8;
constexpr int BATCH = 16, SEQ = 2048, D = 1024, FF = 2816, M = BATCH * SEQ;
constexpr int HG_HEADS = 8, HG_DK = 128, HG_CHUNK = 64, NCHUNK = SEQ / HG_CHUNK;
constexpr int ATT_HEADS = 16, ATT_KVH = 2, ATT_HD = 64, WINDOW = 128, NBLK = SEQ / WINDOW;
constexpr float EPS = 1e-6f;

#ifndef MK_ONE_LAUNCH
#define MK_ONE_LAUNCH 0
#endif

constexpr size_t MiB = 1u << 20;
constexpr size_t SZ_WGU = (size_t)2 * FF * D * 2, SZ_WD = (size_t)D * FF * 2;
constexpr size_t WS_MISC = 0;
constexpr size_t WS_WGU = 1 * MiB;
constexpr size_t WS_WD = WS_WGU + 4 * SZ_WGU;
constexpr size_t WS_WIN = WS_WD + 4 * SZ_WD;
constexpr size_t WS_WHO = WS_WIN + (size_t)4096 * D * 2;
constexpr size_t WS_WKV = WS_WHO + (size_t)D * D * 2;
constexpr size_t WS_WQ = WS_WKV + (size_t)256 * D * 2;
constexpr size_t WS_WAO = WS_WQ + (size_t)D * D * 2;
constexpr size_t WS_WEND = WS_WAO + (size_t)D * D * 2;
constexpr size_t WS_HB = 88 * MiB;
constexpr size_t WS_SSQ = WS_HB + 64 * MiB;
constexpr size_t WS_KB = WS_SSQ + 2 * MiB;
constexpr size_t WS_VB = WS_KB + 8 * MiB;
constexpr size_t WS_R = WS_VB + 8 * MiB;
constexpr size_t WS_ACT = WS_R;
constexpr size_t WS_HQ = WS_R, WS_HLOGF = WS_R + 64 * MiB, WS_HV = WS_R + 192 * MiB, WS_HG = WS_R + 256 * MiB;
constexpr size_t WS_QA = WS_R;
constexpr size_t WS_END = WS_R + 320 * MiB;
static_assert(WS_WEND <= WS_HB && (size_t)M * FF * 2 <= 320 * MiB && WS_END <= 512 * MiB, "d_ws map");

constexpr int LDS_BYTES = 147456;

#define LAS __attribute__((address_space(3)))
typedef unsigned short bf16;
typedef unsigned v4u __attribute__((ext_vector_type(4)));
typedef unsigned v2u __attribute__((ext_vector_type(2)));
typedef float f32x4 __attribute__((ext_vector_type(4)));
typedef float f32x16 __attribute__((ext_vector_type(16)));
typedef short bf16x8 __attribute__((ext_vector_type(8)));
#define LDS_WAIT() asm volatile("s_waitcnt lgkmcnt(0)" ::: "memory")
__device__ __forceinline__ unsigned f2bf(float f) { unsigned u = __builtin_bit_cast(unsigned, f); return (u + 0x7fffu + ((u >> 16) & 1u)) >> 16; }
__device__ __forceinline__ unsigned pk2(float lo, float hi) { return pg8::cvt_pk_bf16(lo, hi); }
__device__ __forceinline__ float bf2f(unsigned short b) { return __builtin_bit_cast(float, (unsigned)b << 16); }
__device__ __forceinline__ float wave_sum(float v) {
#pragma unroll
    for (int o = 1; o < 64; o <<= 1) v += __shfl_xor(v, o);
    return v;
}

template <int MODE> __device__ __forceinline__ int remap_row(int n) {
    if (MODE == 1) { const int bj = n >= FF ? 1 : 0, r = n - bj * FF, t = r >> 7, j = r & 127; return 256 * t + 128 * bj + j; }
    if (MODE == 2) { const int head = n >> 6, d = n & 63, pn = head >> 2, wc = head & 3, bj = d >> 5, j = d & 31; return 256 * pn + 128 * bj + 32 * wc + j; }
    return n;
}
template <int MODE> __device__ __forceinline__ void p0_transpose_item(const float* W, const float* gk, int K, int N, bf16* WT, LAS float* scr, int item, int lane) {
    const int nblk = N / 32, kb = item / nblk, nb = item % nblk, k0 = 64 * kb, n0 = 32 * nb;
#pragma unroll 8
    for (int i = 0; i < 32; ++i) { const int kk = 2 * i + (lane >> 5); const float g = gk ? gk[k0 + kk] : 1.0f; scr[kk * 33 + (lane & 31)] = W[(size_t)(k0 + kk) * N + n0 + (lane & 31)] * g; }
    LDS_WAIT(); asm volatile("" ::: "memory");
    const int c = lane & 7;
#pragma unroll
    for (int j = 0; j < 4; ++j) { const int n = (lane >> 3) + 8 * j; const LAS float* s = scr + (8 * c) * 33 + n;
        v4u o; o.x = pk2(s[0 * 33], s[1 * 33]); o.y = pk2(s[2 * 33], s[3 * 33]); o.z = pk2(s[4 * 33], s[5 * 33]); o.w = pk2(s[6 * 33], s[7 * 33]);
        *(v4u*)(WT + (size_t)remap_row<MODE>(n0 + n) * K + k0 + 8 * c) = o; }
    LDS_WAIT(); asm volatile("" ::: "memory");
}

struct Args {
    const float* x; const float* ffn_norm_g; const float* ffn_w_gate_up; const float* ffn_w_down; const float* mix_norm_g; const float* hgrn_w_in; const float* hgrn_lb_logits;
    const float* hgrn_onorm_g; const float* hgrn_w_out; const float* kv_norm_g; const float* kv_w; const float* k_norm_g; const float* attn_w_q; const float* q_norm_g;
    const float* attn_sinks; const float* attn_w_out;
    float* out; unsigned char* ws; int ph_lo, ph_hi;
};

__device__ __forceinline__ void p0_prologue(const Args& a, LAS unsigned char* lds, int bid, int G, int wave, int lane) {
    LAS float* scr = (LAS float*)(lds + wave * 16384);
    const int gw = bid * NWAVES + wave, NGW = G * NWAVES;
    unsigned char* ws = a.ws;
    constexpr int I_GU = (D / 64) * (2 * FF / 32), I_D = (FF / 64) * (D / 32), I_IN = (D / 64) * (4096 / 32), I_SQ = (D / 64) * (D / 32), I_KV = (D / 64) * (256 / 32);
    constexpr int NITEMS = 4 * I_GU + 4 * I_D + I_IN + 3 * I_SQ + I_KV;
    for (int it = gw; it < NITEMS; it += NGW) {
        int r = it;
        if (r < 4 * I_GU) { const int l = r / I_GU; r -= l * I_GU; p0_transpose_item<1>(a.ffn_w_gate_up + (size_t)l * D * 2 * FF, a.ffn_norm_g + l * D, D, 2 * FF, (bf16*)(ws + WS_WGU + l * SZ_WGU), scr, r, lane); continue; } r -= 4 * I_GU;
        if (r < 4 * I_D) { const int l = r / I_D; r -= l * I_D; p0_transpose_item<0>(a.ffn_w_down + (size_t)l * FF * D, nullptr, FF, D, (bf16*)(ws + WS_WD + l * SZ_WD), scr, r, lane); continue; } r -= 4 * I_D;
        if (r < I_IN) { p0_transpose_item<0>(a.hgrn_w_in, a.mix_norm_g, D, 4096, (bf16*)(ws + WS_WIN), scr, r, lane); continue; } r -= I_IN;
        if (r < I_SQ) { p0_transpose_item<0>(a.hgrn_w_out, nullptr, D, D, (bf16*)(ws + WS_WHO), scr, r, lane); continue; } r -= I_SQ;
        if (r < I_SQ) { p0_transpose_item<2>(a.attn_w_q, a.mix_norm_g + D, D, D, (bf16*)(ws + WS_WQ), scr, r, lane); continue; } r -= I_SQ;
        if (r < I_SQ) { p0_transpose_item<0>(a.attn_w_out, nullptr, D, D, (bf16*)(ws + WS_WAO), scr, r, lane); continue; } r -= I_SQ;
        p0_transpose_item<2>(a.kv_w, a.kv_norm_g, D, 256, (bf16*)(ws + WS_WKV), scr, r, lane);
    }
    bf16* hb = (bf16*)(ws + WS_HB); float* ssq = (float*)(ws + WS_SSQ);
    for (int m = gw; m < M; m += NGW) {
        const f32x4* xr = (const f32x4*)(a.x + (size_t)m * D) + lane; f32x4 v[4]; float s = 0.f;
#pragma unroll
        for (int j = 0; j < 4; ++j) { v[j] = xr[64 * j]; s += (v[j].x * v[j].x + v[j].y * v[j].y) + (v[j].z * v[j].z + v[j].w * v[j].w); }
        s = wave_sum(s);
        unsigned long long* o8 = (unsigned long long*)(hb + (size_t)m * D) + lane;
#pragma unroll
        for (int j = 0; j < 4; ++j) o8[64 * j] = (unsigned long long)pk2(v[j].x, v[j].y) | ((unsigned long long)pk2(v[j].z, v[j].w) << 32);
        if (lane < 16) ssq[(size_t)m * 16 + lane] = lane == 0 ? s : 0.f;
    }
    float* lbv = (float*)(ws + WS_MISC); float* rope = (float*)(ws + WS_MISC + 65536);
    for (int i = gw * 64 + lane; i < 1024; i += NGW * 64) { const float l0 = a.hgrn_lb_logits[i], l1 = a.hgrn_lb_logits[1024 + i]; lbv[i] = 1.0f / (1.0f + expf(l1 - l0)); }
    for (int i = gw * 64 + lane; i < 2048 * 8; i += NGW * 64) { const int pos = i >> 3, k = i & 7;
        const float inv_freq = powf(500000.0f, -(float)k * 0.125f); const float ang = (float)pos * inv_freq;
        rope[2 * i] = cosf(ang); rope[2 * i + 1] = sinf(ang); }
}

constexpr int HQE = 0, HKE = 17408, HKDT = 34816, HVT = 53248, HSC = 71680, HBEND = 80896, HCUM = 81408, HNRM = 83456;
constexpr int PQ = 272, PT = 144;
__device__ __forceinline__ void hgrn_phase(LAS unsigned char* lds, const bf16* qb, const float* logf, const bf16* vb, const bf16* gb, bf16* og, const float* onorm_g, int G, int bid, int tid, int w, int lane) {
    const int g = lane >> 4, lr = lane & 15;
    const int dk = tid & 127, grp = tid >> 7;
    LAS float* CUM = (LAS float*)(lds + HCUM); LAS float* BEND = (LAS float*)(lds + HBEND); LAS float* NRM = (LAS float*)(lds + HNRM);
    for (int item = bid; item < BATCH * HG_HEADS; item += G) {
        const int b = item >> 3, head = item & 7, colbase = head * 128;
        f32x4 S[8];
#pragma unroll
        for (int j = 0; j < 8; ++j) S[j] = (f32x4){0.f, 0.f, 0.f, 0.f};
        const f32x4 gnv = *(const f32x4*)(onorm_g + 16 * w + 4 * g);
        for (int c = 0; c < NCHUNK; ++c) {
            const size_t row0 = (size_t)b * SEQ + c * HG_CHUNK;
            float l[16], qv[16]; unsigned short vv[16];
            { const size_t base = (row0 + 16 * grp) * 1024 + colbase + dk;
#pragma unroll
              for (int i = 0; i < 16; ++i) { l[i] = logf[base + (size_t)i * 1024]; qv[i] = bf2f(qb[base + (size_t)i * 1024]); vv[i] = vb[base + (size_t)i * 1024]; } }
            float cb[16]; float run = 0.f;
#pragma unroll
            for (int i = 0; i < 16; ++i) { run += l[i]; cb[i] = run; }
            CUM[grp * 128 + dk] = run;
            LDS_WAIT(); __builtin_amdgcn_s_barrier(); asm volatile("" ::: "memory");
            const float c0 = CUM[dk], c1 = CUM[128 + dk], c2 = CUM[256 + dk], c3 = CUM[384 + dk];
            const float prefix = (grp > 0 ? c0 : 0.f) + (grp > 1 ? c1 : 0.f) + (grp > 2 ? c2 : 0.f);
            const float tot = ((c0 + c1) + c2) + c3;
            unsigned short kd[16];
#pragma unroll
            for (int i = 0; i < 16; ++i) {
                const float bb = prefix + cb[i]; const float k = 1.0f - __expf(l[i]);
                const float qe = qv[i] * __expf(bb), ke = k * __expf(-bb), kdv = k * __expf(tot - bb);
                const int s = 16 * grp + i;
                *(LAS unsigned short*)(lds + HQE + s * PQ + dk * 2) = (unsigned short)f2bf(qe);
                *(LAS unsigned short*)(lds + HKE + s * PQ + dk * 2) = (unsigned short)f2bf(ke);
                kd[i] = (unsigned short)f2bf(kdv);
            }
            { v4u a, bq, va, vq;
              a.x = kd[0] | ((unsigned)kd[1] << 16); a.y = kd[2] | ((unsigned)kd[3] << 16); a.z = kd[4] | ((unsigned)kd[5] << 16); a.w = kd[6] | ((unsigned)kd[7] << 16);
              bq.x = kd[8] | ((unsigned)kd[9] << 16); bq.y = kd[10] | ((unsigned)kd[11] << 16); bq.z = kd[12] | ((unsigned)kd[13] << 16); bq.w = kd[14] | ((unsigned)kd[15] << 16);
              va.x = vv[0] | ((unsigned)vv[1] << 16); va.y = vv[2] | ((unsigned)vv[3] << 16); va.z = vv[4] | ((unsigned)vv[5] << 16); va.w = vv[6] | ((unsigned)vv[7] << 16);
              vq.x = vv[8] | ((unsigned)vv[9] << 16); vq.y = vv[10] | ((unsigned)vv[11] << 16); vq.z = vv[12] | ((unsigned)vv[13] << 16); vq.w = vv[14] | ((unsigned)vv[15] << 16);
              *(LAS v4u*)(lds + HKDT + dk * PT + grp * 32) = a; *(LAS v4u*)(lds + HKDT + dk * PT + grp * 32 + 16) = bq;
              *(LAS v4u*)(lds + HVT + dk * PT + grp * 32) = va; *(LAS v4u*)(lds + HVT + dk * PT + grp * 32 + 16) = vq; }
            if (grp == 0) BEND[dk] = __expf(tot);
            LDS_WAIT(); __builtin_amdgcn_s_barrier(); asm volatile("" ::: "memory");
            { const int tt = w >> 1;
#pragma unroll
              for (int s2 = 0; s2 < 2; ++s2) { const int st = 2 * (w & 1) + s2; f32x4 cacc = (f32x4){0.f, 0.f, 0.f, 0.f};
                if (st <= tt) {
#pragma unroll
                    for (int kk = 0; kk < 4; ++kk) { const bf16x8 af = *(const LAS bf16x8*)(lds + HQE + (16 * tt + lr) * PQ + (32 * kk + 8 * g) * 2);
                        const bf16x8 bf = *(const LAS bf16x8*)(lds + HKE + (16 * st + lr) * PQ + (32 * kk + 8 * g) * 2);
                        cacc = __builtin_amdgcn_mfma_f32_16x16x32_bf16(af, bf, cacc, 0, 0, 0); }
                    if (st == tt) {
#pragma unroll
                        for (int e = 0; e < 4; ++e) if (lr > 4 * g + e) cacc[e] = 0.f;
                    }
                }
#pragma unroll
                for (int e = 0; e < 4; ++e) *(LAS unsigned short*)(lds + HSC + (16 * tt + 4 * g + e) * PT + (16 * st + lr) * 2) = (unsigned short)f2bf(cacc[e]);
              } }
            f32x4 o[4];
#pragma unroll
            for (int t4 = 0; t4 < 4; ++t4) o[t4] = (f32x4){0.f, 0.f, 0.f, 0.f};
            {
                bf16x8 sf[4];
#pragma unroll
                for (int kk = 0; kk < 4; ++kk) { v4u p; p.x = pk2(S[2 * kk][0], S[2 * kk][1]); p.y = pk2(S[2 * kk][2], S[2 * kk][3]); p.z = pk2(S[2 * kk + 1][0], S[2 * kk + 1][1]); p.w = pk2(S[2 * kk + 1][2], S[2 * kk + 1][3]);
                    sf[kk] = __builtin_bit_cast(bf16x8, p); }
#pragma unroll
                for (int t4 = 0; t4 < 4; ++t4)
#pragma unroll
                    for (int kk = 0; kk < 4; ++kk) {
                        const v2u lo = *(const LAS v2u*)(lds + HQE + (16 * t4 + lr) * PQ + (32 * kk + 4 * g) * 2), hi = *(const LAS v2u*)(lds + HQE + (16 * t4 + lr) * PQ + (32 * kk + 16 + 4 * g) * 2);
                        v4u q4; q4.x = lo.x; q4.y = lo.y; q4.z = hi.x; q4.w = hi.y;
                        o[t4] = __builtin_amdgcn_mfma_f32_16x16x32_bf16(sf[kk], __builtin_bit_cast(bf16x8, q4), o[t4], 0, 0, 0);
                    }
            }
            bf16x8 vf[2];
#pragma unroll
            for (int ks = 0; ks < 2; ++ks) vf[ks] = *(const LAS bf16x8*)(lds + HVT + (16 * w + lr) * PT + (32 * ks + 8 * g) * 2);
#pragma unroll
            for (int j = 0; j < 8; ++j) { const f32x4 dec = *(const LAS f32x4*)(lds + HBEND + (16 * j + 4 * g) * 4); S[j] = S[j] * dec;
#pragma unroll
                for (int ks = 0; ks < 2; ++ks) { const bf16x8 af = *(const LAS bf16x8*)(lds + HKDT + (16 * j + lr) * PT + (32 * ks + 8 * g) * 2);
                    S[j] = __builtin_amdgcn_mfma_f32_16x16x32_bf16(af, vf[ks], S[j], 0, 0, 0); } }
            v2u gt[4];
#pragma unroll
            for (int t4 = 0; t4 < 4; ++t4) gt[t4] = *(const v2u*)(gb + (row0 + 16 * t4 + lr) * 1024 + colbase + 16 * w + 4 * g);
            LDS_WAIT(); __builtin_amdgcn_s_barrier(); asm volatile("" ::: "memory");
#pragma unroll
            for (int t4 = 0; t4 < 4; ++t4)
#pragma unroll
                for (int ks = 0; ks < 2; ++ks) if (2 * ks <= t4) {
                    const bf16x8 bf = *(const LAS bf16x8*)(lds + HSC + (16 * t4 + lr) * PT + (32 * ks + 8 * g) * 2);
                    o[t4] = __builtin_amdgcn_mfma_f32_16x16x32_bf16(vf[ks], bf, o[t4], 0, 0, 0);
                }
#pragma unroll
            for (int t4 = 0; t4 < 4; ++t4) { float ss = (o[t4][0] * o[t4][0] + o[t4][1] * o[t4][1]) + (o[t4][2] * o[t4][2] + o[t4][3] * o[t4][3]); ss += __shfl_xor(ss, 16); ss += __shfl_xor(ss, 32);
                if (g == 0) NRM[(16 * t4 + lr) * 8 + w] = ss; }
            LDS_WAIT(); __builtin_amdgcn_s_barrier(); asm volatile("" ::: "memory");
#pragma unroll
            for (int t4 = 0; t4 < 4; ++t4) { const int t = 16 * t4 + lr; const f32x4 na = *(const LAS f32x4*)(lds + HNRM + t * 32), nb = *(const LAS f32x4*)(lds + HNRM + t * 32 + 16);
                const float tot2 = ((na[0] + na[1]) + (na[2] + na[3])) + ((nb[0] + nb[1]) + (nb[2] + nb[3])); const float r = 1.0f / sqrtf(tot2 * (1.0f / 128.0f) + EPS);
                const float g0 = bf2f((unsigned short)(gt[t4].x & 0xffffu)), g1 = bf2f((unsigned short)(gt[t4].x >> 16)), g2 = bf2f((unsigned short)(gt[t4].y & 0xffffu)), g3 = bf2f((unsigned short)(gt[t4].y >> 16));
                v2u ov; ov.x = pk2(o[t4][0] * r * gnv[0] * g0, o[t4][1] * r * gnv[1] * g1); ov.y = pk2(o[t4][2] * r * gnv[2] * g2, o[t4][3] * r * gnv[3] * g3);
                *(v2u*)(og + (row0 + t) * 1024 + colbase + 16 * w + 4 * g) = ov; }
        }
    }
}

constexpr int AKB = 0, APK = 144, AVT = 36864, APV = 528;
__device__ __forceinline__ void attn_phase(LAS unsigned char* lds, const bf16* qa, const bf16* kb, const bf16* vb, bf16* ao, const float* sinks, int G, int bid, int tid, int w, int lane) {
    const int h = lane >> 5, tl = lane & 31;
    for (int item = bid; item < BATCH * NBLK * ATT_KVH; item += G) {
        const int b = item >> 5, blk = (item >> 1) & 15, kvh = item & 1;
        __syncthreads();
        { const int r = tid >> 1, hf = tid & 1;
          if (blk > 0 || r >= 128) {
              const size_t grow = (size_t)b * SEQ + (blk - 1) * WINDOW + r;
              const v4u* kp = (const v4u*)(kb + grow * 128 + kvh * 64 + hf * 32); const v4u* vp = (const v4u*)(vb + grow * 128 + kvh * 64 + hf * 32);
              v4u kx[4], vx[4];
#pragma unroll
              for (int i = 0; i < 4; ++i) { kx[i] = kp[i]; vx[i] = vp[i]; }
#pragma unroll
              for (int i = 0; i < 4; ++i) *(LAS v4u*)(lds + AKB + r * APK + (hf * 32 + 8 * i) * 2) = kx[i];
#pragma unroll
              for (int i = 0; i < 4; ++i) {
                  const unsigned wd[4] = {vx[i].x, vx[i].y, vx[i].z, vx[i].w};
#pragma unroll
                  for (int e = 0; e < 4; ++e) { const int d = hf * 32 + 8 * i + 2 * e;
                      *(LAS unsigned short*)(lds + AVT + d * APV + r * 2) = (unsigned short)(wd[e] & 0xffffu);
                      *(LAS unsigned short*)(lds + AVT + (d + 1) * APV + r * 2) = (unsigned short)(wd[e] >> 16); }
              }
          } }
        __syncthreads();
        const int head = kvh * 8 + w; const float sink = sinks[head];
#pragma unroll 1
        for (int tq = 0; tq < 4; ++tq) {
            const size_t qrow = (size_t)b * SEQ + blk * WINDOW + 32 * tq + tl;
            bf16x8 qf[4];
#pragma unroll
            for (int kk = 0; kk < 4; ++kk) qf[kk] = *(const bf16x8*)(qa + qrow * 1024 + head * 64 + 16 * kk + 8 * h);
            const int jlo = blk == 0 ? 4 : 0;
            f32x16 S[5];
#pragma unroll
            for (int jj = 0; jj < 5; ++jj) {
                const int j = tq + jj;
#pragma unroll
                for (int e = 0; e < 16; ++e) S[jj][e] = 0.f;
                if (j >= jlo) {
#pragma unroll
                    for (int kk = 0; kk < 4; ++kk) { const bf16x8 kf = *(const LAS bf16x8*)(lds + AKB + (32 * j + tl) * APK + (16 * kk + 8 * h) * 2);
                        S[jj] = __builtin_amdgcn_mfma_f32_32x32x16_bf16(kf, qf[kk], S[jj], 0, 0, 0); }
                }
            }
            float mx = sink;
#pragma unroll
            for (int jj = 0; jj < 5; ++jj) { const bool on = (tq + jj) >= jlo;
#pragma unroll
                for (int e = 0; e < 16; ++e) { const int sl = (e & 3) + 8 * (e >> 2) + 4 * h;
                    bool ok = on; if (jj == 0) ok = ok && (sl > tl); if (jj == 4) ok = ok && (sl <= tl);
                    S[jj][e] = ok ? S[jj][e] : -INFINITY; mx = fmaxf(mx, S[jj][e]); } }
            mx = fmaxf(mx, __shfl_xor(mx, 32));
            float sum = 0.f;
#pragma unroll
            for (int jj = 0; jj < 5; ++jj)
#pragma unroll
                for (int e = 0; e < 16; ++e) { S[jj][e] = __expf(S[jj][e] - mx); sum += S[jj][e]; }
            sum += __shfl_xor(sum, 32); sum += __expf(sink - mx);
            const float inv = 1.0f / sum;
            f32x16 O[2];
#pragma unroll
            for (int dt = 0; dt < 2; ++dt)
#pragma unroll
                for (int e = 0; e < 16; ++e) O[dt][e] = 0.f;
#pragma unroll
            for (int jj = 0; jj < 5; ++jj) { const int j = tq + jj;
                if (j >= jlo) {
#pragma unroll
                    for (int a2 = 0; a2 < 2; ++a2) {
                        v4u pp; pp.x = pk2(S[jj][8 * a2 + 0], S[jj][8 * a2 + 1]); pp.y = pk2(S[jj][8 * a2 + 2], S[jj][8 * a2 + 3]); pp.z = pk2(S[jj][8 * a2 + 4], S[jj][8 * a2 + 5]); pp.w = pk2(S[jj][8 * a2 + 6], S[jj][8 * a2 + 7]);
                        const bf16x8 pf = __builtin_bit_cast(bf16x8, pp);
#pragma unroll
                        for (int dt = 0; dt < 2; ++dt) {
                            const v2u lo = *(const LAS v2u*)(lds + AVT + (32 * dt + tl) * APV + (32 * j + 16 * a2 + 4 * h) * 2), hi = *(const LAS v2u*)(lds + AVT + (32 * dt + tl) * APV + (32 * j + 16 * a2 + 8 + 4 * h) * 2);
                            v4u v4; v4.x = lo.x; v4.y = lo.y; v4.z = hi.x; v4.w = hi.y;
                            O[dt] = __builtin_amdgcn_mfma_f32_32x32x16_bf16(__builtin_bit_cast(bf16x8, v4), pf, O[dt], 0, 0, 0);
                        }
                    }
                }
            }
#pragma unroll
            for (int dt = 0; dt < 2; ++dt)
#pragma unroll
                for (int rg = 0; rg < 4; ++rg) { v2u ov; ov.x = pk2(O[dt][4 * rg] * inv, O[dt][4 * rg + 1] * inv); ov.y = pk2(O[dt][4 * rg + 2] * inv, O[dt][4 * rg + 3] * inv);
                    *(v2u*)(ao + qrow * 1024 + head * 64 + 32 * dt + 8 * rg + 4 * h) = ov; }
        }
    }
}

__global__ void __launch_bounds__(NWAVES * 64, 2) yoco_fwd(Args args) {
    extern __shared__ __attribute__((aligned(16))) unsigned char lds_raw[];
    LAS unsigned char* lds = (LAS unsigned char*)lds_raw;
    const int tid = threadIdx.x, lane = tid & 63, wave = __builtin_amdgcn_readfirstlane(tid >> 6);
    const int G = gridDim.x, bid = blockIdx.x;
    unsigned char* ws = args.ws;
    bf16* hb = (bf16*)(ws + WS_HB); float* ssq = (float*)(ws + WS_SSQ); bf16* act = (bf16*)(ws + WS_ACT);
    const float* lbv = (const float*)(ws + WS_MISC); const float* rope = (const float*)(ws + WS_MISC + 65536);
    const int lo = args.ph_lo, hi = args.ph_hi;
#define IN(k) (lo <= (k) && (k) < hi)
#define SEAM(k) do { if (IN(k) && IN((k) + 1)) { cg::this_grid().sync(); } } while (0)
    typedef pg8::StaticOrder SO;
#define GEMM_PHASE(EPI, Aptr, Bptr, NN, KK, Eobj) do { pg8::Gemm g_{(const pg8::bf16_t*)(Aptr), (const pg8::bf16_t*)(Bptr), M, (NN), (KK)}; SO S_; S_.init(M, (NN), G, bid); \
        pg8::gemm_phase<EPI, SO, true, true>(lds, g_, S_, Eobj); } while (0)

    if (IN(0)) { p0_prologue(args, lds, bid, G, wave, lane); } SEAM(0);
    if (IN(1)) { pg8::EpiSwiGLU E{act, ssq}; GEMM_PHASE(pg8::EpiSwiGLU, hb, ws + WS_WGU + 0 * SZ_WGU, 2 * FF, D, E); } SEAM(1);
    if (IN(2)) { pg8::EpiResid E{args.x, args.out, hb, ssq, 0.5f, 1}; GEMM_PHASE(pg8::EpiResid, act, ws + WS_WD + 0 * SZ_WD, D, FF, E); } SEAM(2);
    if (IN(3)) { pg8::EpiHgrnIn E{(bf16*)(ws + WS_HQ), (float*)(ws + WS_HLOGF), (long)((WS_HV - WS_HQ) / 2), (long)((WS_HG - WS_HQ) / 2), lbv, ssq}; GEMM_PHASE(pg8::EpiHgrnIn, hb, ws + WS_WIN, 4096, D, E); } SEAM(3);
    if (IN(4)) { hgrn_phase(lds, (const bf16*)(ws + WS_HQ), (const float*)(ws + WS_HLOGF), (const bf16*)(ws + WS_HV), (const bf16*)(ws + WS_HG), (bf16*)(ws + WS_HQ), args.hgrn_onorm_g, G, bid, tid, wave, lane); } SEAM(4);
    if (IN(5)) { pg8::EpiResid E{args.out, args.out, hb, ssq, 1.0f, 1}; GEMM_PHASE(pg8::EpiResid, ws + WS_HQ, ws + WS_WHO, D, D, E); } SEAM(5);
    if (IN(6)) { pg8::EpiSwiGLU E{act, ssq}; GEMM_PHASE(pg8::EpiSwiGLU, hb, ws + WS_WGU + 1 * SZ_WGU, 2 * FF, D, E); } SEAM(6);
    if (IN(7)) { pg8::EpiResid E{args.out, args.out, hb, ssq, 0.5f, 1}; GEMM_PHASE(pg8::EpiResid, act, ws + WS_WD + 1 * SZ_WD, D, FF, E); } SEAM(7);
    if (IN(8)) { pg8::EpiHead<false> E{(bf16*)(ws + WS_KB), (long)((WS_VB - WS_KB) / 2), args.k_norm_g, rope, ssq, 1.0f}; GEMM_PHASE(pg8::EpiHead<false>, hb, ws + WS_WKV, 256, D, E);
                 __syncthreads();
                 pg8::EpiSwiGLU E2{act, ssq}; GEMM_PHASE(pg8::EpiSwiGLU, hb, ws + WS_WGU + 2 * SZ_WGU, 2 * FF, D, E2); } SEAM(8);
    if (IN(9)) { pg8::EpiResid E{args.out, args.out, hb, ssq, 0.5f, 1}; GEMM_PHASE(pg8::EpiResid, act, ws + WS_WD + 2 * SZ_WD, D, FF, E); } SEAM(9);
    if (IN(10)) { pg8::EpiHead<true> E{(bf16*)(ws + WS_QA), 0l, args.q_norm_g, rope, ssq, 0.125f}; GEMM_PHASE(pg8::EpiHead<true>, hb, ws + WS_WQ, D, D, E); } SEAM(10);
    if (IN(11)) { attn_phase(lds, (const bf16*)(ws + WS_QA), (const bf16*)(ws + WS_KB), (const bf16*)(ws + WS_VB), (bf16*)(ws + WS_QA), args.attn_sinks, G, bid, tid, wave, lane); } SEAM(11);
    if (IN(12)) { pg8::EpiResid E{args.out, args.out, hb, ssq, 1.0f, 1}; GEMM_PHASE(pg8::EpiResid, ws + WS_QA, ws + WS_WAO, D, D, E); } SEAM(12);
    if (IN(13)) { pg8::EpiSwiGLU E{act, ssq}; GEMM_PHASE(pg8::EpiSwiGLU, hb, ws + WS_WGU + 3 * SZ_WGU, 2 * FF, D, E); } SEAM(13);
    if (IN(14)) { pg8::EpiResid E{args.out, args.out, hb, ssq, 0.5f, 0}; GEMM_PHASE(pg8::EpiResid, act, ws + WS_WD + 3 * SZ_WD, D, FF, E); }
#undef IN
#undef SEAM
#undef GEMM_PHASE
}
constexpr int N_PHASES = 15;

extern "C" void kernel_launch(void* const* d_in, const int* in_sizes, int n_in, void* d_out, int out_size, void* d_ws, size_t ws_size, hipStream_t stream) {
    static int grid = 0;
    if (grid == 0) {
        if (n_in != 16 || in_sizes[0] != M * D || out_size != M * D || ws_size < WS_END) { fprintf(stderr, "kernel_launch: unexpected problem (n_in %d, in0 %d, out %d, ws %zu, need %zu)\n", n_in, n_in > 0 ? in_sizes[0] : -1, out_size, ws_size, (size_t)WS_END); grid = -1; return; }
        int dev = 0, cus = 0, per_cu = 0;
        if (hipGetDevice(&dev) != hipSuccess || hipDeviceGetAttribute(&cus, hipDeviceAttributeMultiprocessorCount, dev) != hipSuccess) { grid = -1; return; }
        if (hipFuncSetAttribute((const void*)yoco_fwd, hipFuncAttributeMaxDynamicSharedMemorySize, LDS_BYTES) != hipSuccess) { fprintf(stderr, "kernel_launch: hipFuncSetAttribute failed\n"); grid = -1; return; }
        if (hipOccupancyMaxActiveBlocksPerMultiprocessor(&per_cu, (const void*)yoco_fwd, NWAVES * 64, LDS_BYTES) != hipSuccess || per_cu < 1) { fprintf(stderr, "kernel_launch: occupancy query says %d\n", per_cu); per_cu = 1; }
        (void)hipGetLastError();
        grid = cus;
    }
    if (grid < 0) return;
    Args a{};
    a.x = (const float*)d_in[0]; a.ffn_norm_g = (const float*)d_in[1]; a.ffn_w_gate_up = (const float*)d_in[2]; a.ffn_w_down = (const float*)d_in[3]; a.mix_norm_g = (const float*)d_in[4];
    a.hgrn_w_in = (const float*)d_in[5]; a.hgrn_lb_logits = (const float*)d_in[6]; a.hgrn_onorm_g = (const float*)d_in[7]; a.hgrn_w_out = (const float*)d_in[8]; a.kv_norm_g = (const float*)d_in[9];
    a.kv_w = (const float*)d_in[10]; a.k_norm_g = (const float*)d_in[11]; a.attn_w_q = (const float*)d_in[12]; a.q_norm_g = (const float*)d_in[13]; a.attn_sinks = (const float*)d_in[14]; a.attn_w_out = (const float*)d_in[15];
    a.out = (float*)d_out; a.ws = (unsigned char*)d_ws;
#if MK_ONE_LAUNCH
    a.ph_lo = 0; a.ph_hi = N_PHASES;
    void* kargs[] = {&a};
    hipError_t e = hipLaunchCooperativeKernel((const void*)yoco_fwd, dim3(grid), dim3(NWAVES * 64), kargs, LDS_BYTES, stream);
    if (e != hipSuccess) fprintf(stderr, "kernel_launch: cooperative launch failed: %s (grid %d)\n", hipGetErrorString(e), grid);
#else
    for (int p = 0; p < N_PHASES; ++p) { a.ph_lo = p; a.ph_hi = p + 1; hipLaunchKernelGGL(yoco_fwd, dim3(grid), dim3(NWAVES * 64), LDS_BYTES, stream, a); }
#endif
}
```

```cpp
#include <hip/hip_runtime.h>
#include <hip/hip_cooperative_groups.h>
#include <cstdio>
#include <cstdint>
namespace cg = cooperative_groups;
namespace pg8 {
#define PG8_LAS __attribute__((address_space(3)))
typedef unsigned short bf16_t;
typedef short bf16x8 __attribute__((ext_vector_type(8)));
typedef float f32x4 __attribute__((ext_vector_type(4)));
typedef unsigned u32x4 __attribute__((ext_vector_type(4)));
constexpr int BM = 256, BK = 64, HALF = 128, HTB = HALF * BK * 2  , STAGE_BYTES = 8 * HTB, NXCD = 8, WGM = 4;

__host__ __device__ __forceinline__ int lds_byte(int r, int c) { const int st = (r >> 4) * 2 + (c >> 5), rr = r & 15, cc = c & 31, ob = rr * 64 + cc * 2; return st * 1024 + (ob ^ (((ob >> 9) & 1) << 5)); }
__host__ __device__ __forceinline__ void stage_rc(int b, int& R, int& C) { const int st = b / 1024, sb = b % 1024, swz = sb ^ (((sb >> 9) & 1) << 5); R = (st >> 1) * 16 + swz / 64; C = (st & 1) * 32 + (swz % 64) / 2; }
__host__ __device__ __forceinline__ int perm32(int rho) { const int n = rho >> 4, i = rho & 15; return 8 * (i >> 2) + 4 * n + (i & 3); }

struct Unit { int pm, pn; };
struct Gemm { const bf16_t* A; const bf16_t* Bt; int M, N, K; };

struct StaticOrder {
    int nM, nN, nwg, G, c;
    __host__ __device__ void init(int M, int N, int G_, int c_) { nM = M / BM; nN = N / BM; nwg = nM * nN; G = G_; c = c_; }
    __host__ __device__ bool next(int i, Unit& u) const {
        const long L = (long)i * G + c; if (L >= nwg) return false;
        int wgid = (int)L; { const int q = nwg / NXCD, r = nwg % NXCD, xcd = wgid % NXCD, off = wgid / NXCD; wgid = (xcd < r ? xcd * (q + 1) : r * (q + 1) + (xcd - r) * q) + off; }
        const int nig = WGM * nN, gid = wgid / nig, fm = gid * WGM, gsz = (nM - fm) < WGM ? (nM - fm) : WGM;
        u.pm = fm + ((wgid % nig) % gsz); u.pn = (wgid % nig) / gsz; return true;
    }
    __device__ __forceinline__ void a_ready(const Unit&) const {}
    __device__ __forceinline__ void done(const Unit&) const {}
};

__device__ __forceinline__ unsigned cvt_pk_bf16(float lo, float hi) { unsigned r; asm volatile("v_cvt_pk_bf16_f32 %0, %1, %2" : "=v"(r) : "v"(lo), "v"(hi)); return r; }
typedef float f32x2 __attribute__((ext_vector_type(2)));
#ifndef MK_WT_STORES
#define MK_WT_STORES 0
#endif
__device__ __forceinline__ void st16(void* p, u32x4 v) {
#if MK_WT_STORES
    asm volatile("global_store_dwordx4 %0, %1, off sc1\n\ts_nop 1" :: "v"(p), "v"(v) : "memory");
#else
    *(u32x4*)p = v;
#endif
}
__device__ __forceinline__ float fast_rcp(float x) { return __builtin_amdgcn_rcpf(x); }
__device__ __forceinline__ float silu_f(float x) { return x * fast_rcp(1.0f + __expf(-x)); }
__device__ __forceinline__ float sigmoid_f(float x) { return fast_rcp(1.0f + __expf(-x)); }
__device__ __forceinline__ float row_rstd(const float* ssq, int row) {
    const f32x4* p = (const f32x4*)(ssq + (size_t)row * 16);
    const f32x4 a = p[0], b = p[1], c = p[2], d = p[3];
    const float s = (((a[0] + a[1]) + (a[2] + a[3])) + ((b[0] + b[1]) + (b[2] + b[3]))) + (((c[0] + c[1]) + (c[2] + c[3])) + ((d[0] + d[1]) + (d[2] + d[3])));
    return 1.0f / sqrtf(s * (1.0f / 1024.0f) + 1e-6f);
}
__device__ __forceinline__ void row_rstd8(const float* ssq, int row0, int fq, float (&rs)[8]) {
    f32x4 pv[8];
#pragma unroll
    for (int r = 0; r < 8; ++r) pv[r] = *(const f32x4*)(ssq + (size_t)(row0 + (r >> 2) * HALF + (r & 3) * 16) * 16 + 4 * fq);
#pragma unroll
    for (int r = 0; r < 8; ++r) { float t = (pv[r][0] + pv[r][1]) + (pv[r][2] + pv[r][3]); t += __shfl_xor(t, 16); t += __shfl_xor(t, 32); rs[r] = 1.0f / sqrtf(t * (1.0f / 1024.0f) + 1e-6f); }
}
struct EpiSwiGLU {
    static constexpr bool PERM = true, AFTER_DRAIN = false;
    bf16_t* O; const float* ssq;
    __device__ __forceinline__ void operator()(const f32x4 (&acc)[2][2][4][2], const Unit& u, int wr, int wc, int fr, int fq) const {
        typedef float f2 __attribute__((ext_vector_type(2)));
        const int row0 = u.pm * BM + wr * 64 + fr, col0 = u.pn * 128 + wc * 32 + 8 * fq;
        float rsv[8]; row_rstd8(ssq, row0, fq, rsv);
#pragma unroll
        for (int ai = 0; ai < 2; ++ai)
#pragma unroll
            for (int m = 0; m < 4; ++m) {
                const int row = row0 + ai * HALF + m * 16; const float rs = rsv[ai * 4 + m];
                const float nrl = rs * -1.4426950408889634f, rs2 = rs * rs;
                unsigned w4[4];
#pragma unroll
                for (int n = 0; n < 2; ++n)
#pragma unroll
                    for (int e = 0; e < 4; e += 2) {
                        const f2 g = (f2){acc[ai][0][m][n][e], acc[ai][0][m][n][e + 1]}, up = (f2){acc[ai][1][m][n][e], acc[ai][1][m][n][e + 1]};
                        const f2 t = g * nrl; f2 ex; ex.x = __builtin_amdgcn_exp2f(t.x); ex.y = __builtin_amdgcn_exp2f(t.y);
                        const f2 d = ex + 1.0f; f2 r; r.x = __builtin_amdgcn_rcpf(d.x); r.y = __builtin_amdgcn_rcpf(d.y);
                        const f2 o = ((g * up) * rs2) * r;
                        w4[2 * n + (e >> 1)] = cvt_pk_bf16(o.x, o.y);
                    }
                u32x4 w; w.x = w4[0]; w.y = w4[1]; w.z = w4[2]; w.w = w4[3];
                st16(O + (size_t)row * 2816 + col0, w);
            }
    }
};
template <bool FINAL> struct EpiResid {
    static constexpr bool PERM = true, AFTER_DRAIN = false;
    bf16_t* hb; float* ssq; float* out; float scale;
    __device__ __forceinline__ void operator()(const f32x4 (&acc)[2][2][4][2], const Unit& u, int wr, int wc, int fr, int fq) const {
        const int row0 = u.pm * BM + wr * 64 + fr, col0 = u.pn * BM + wc * 32 + 8 * fq;
        u32x4 bs[2][4][2];
#pragma unroll
        for (int ai = 0; ai < 2; ++ai)
#pragma unroll
            for (int m = 0; m < 4; ++m)
#pragma unroll
                for (int bj = 0; bj < 2; ++bj) bs[ai][m][bj] = *(const u32x4*)(hb + (size_t)(row0 + ai * HALF + m * 16) * 1024 + col0 + bj * HALF);
#pragma unroll
        for (int ai = 0; ai < 2; ++ai) {
#pragma unroll
            for (int m = 0; m < 4; ++m) {
                const int row = row0 + ai * HALF + m * 16; const size_t off = (size_t)row * 1024 + col0; float ss = 0.f;
#pragma unroll
                for (int bj = 0; bj < 2; ++bj) {
                    const u32x4 b = bs[ai][m][bj];
                    f32x4 o0, o1;
                    o0[0] = __builtin_bit_cast(float, b.x << 16) + acc[ai][bj][m][0][0] * scale; o0[1] = __builtin_bit_cast(float, b.x & 0xffff0000u) + acc[ai][bj][m][0][1] * scale;
                    o0[2] = __builtin_bit_cast(float, b.y << 16) + acc[ai][bj][m][0][2] * scale; o0[3] = __builtin_bit_cast(float, b.y & 0xffff0000u) + acc[ai][bj][m][0][3] * scale;
                    o1[0] = __builtin_bit_cast(float, b.z << 16) + acc[ai][bj][m][1][0] * scale; o1[1] = __builtin_bit_cast(float, b.z & 0xffff0000u) + acc[ai][bj][m][1][1] * scale;
                    o1[2] = __builtin_bit_cast(float, b.w << 16) + acc[ai][bj][m][1][2] * scale; o1[3] = __builtin_bit_cast(float, b.w & 0xffff0000u) + acc[ai][bj][m][1][3] * scale;
                    if (FINAL) { *(f32x4*)(out + off + bj * HALF) = o0; *(f32x4*)(out + off + bj * HALF + 4) = o1; }
                    else { u32x4 w; w.x = cvt_pk_bf16(o0[0], o0[1]); w.y = cvt_pk_bf16(o0[2], o0[3]); w.z = cvt_pk_bf16(o1[0], o1[1]); w.w = cvt_pk_bf16(o1[2], o1[3]); st16(hb + off + bj * HALF, w);
                        ss += ((o0[0] * o0[0] + o0[1] * o0[1]) + (o0[2] * o0[2] + o0[3] * o0[3])) + ((o1[0] * o1[0] + o1[1] * o1[1]) + (o1[2] * o1[2] + o1[3] * o1[3])); }
                }
                if (!FINAL) { ss += __shfl_xor(ss, 16); ss += __shfl_xor(ss, 32); if (fq == 0) ssq[(size_t)row * 16 + u.pn * 4 + wc] = ss; }
            }
        }
    }
};
struct EpiHgrnIn {
    static constexpr bool PERM = true, AFTER_DRAIN = false;
    bf16_t* qb; float* logf; long off_v; long off_g; const float* lbv; const float* ssq;
    template <int REGION> __device__ __forceinline__ void body(const f32x4 (&acc)[2][2][4][2], const Unit& u, int wr, int wc, int fr, int fq) const {
        typedef float f2 __attribute__((ext_vector_type(2)));
        const int row0 = u.pm * BM + wr * 64 + fr, col0 = (u.pn & 3) * BM + wc * 32 + 8 * fq;
        float rsv[8]; row_rstd8(ssq, row0, fq, rsv);
        f32x4 lb[2][2];
        if (REGION == 1) {
#pragma unroll
            for (int bj = 0; bj < 2; ++bj)
#pragma unroll
                for (int n = 0; n < 2; ++n) lb[bj][n] = *(const f32x4*)(lbv + col0 + bj * HALF + 4 * n);
        }
        bf16_t* dst = REGION == 0 ? qb : (REGION == 1 ? (bf16_t*)logf : (REGION == 2 ? qb + off_v : qb + off_g));
#pragma unroll
        for (int ai = 0; ai < 2; ++ai)
#pragma unroll
            for (int m = 0; m < 4; ++m) {
                const int row = row0 + ai * HALF + m * 16; const float rs = rsv[ai * 4 + m]; const size_t off = (size_t)row * 1024 + col0;
                const float nrl = rs * -1.4426950408889634f;
#pragma unroll
                for (int bj = 0; bj < 2; ++bj) {
                    f32x4 vv[2];
#pragma unroll
                    for (int n = 0; n < 2; ++n)
#pragma unroll
                        for (int e = 0; e < 4; e += 2) {
                            const f2 a = (f2){acc[ai][bj][m][n][e], acc[ai][bj][m][n][e + 1]};
                            f2 o;
                            if (REGION == 2) o = a * rs;
                            else {
                                const f2 t = a * nrl; f2 ex; ex.x = __builtin_amdgcn_exp2f(t.x); ex.y = __builtin_amdgcn_exp2f(t.y);
                                const f2 d = ex + 1.0f; f2 sg; sg.x = __builtin_amdgcn_rcpf(d.x); sg.y = __builtin_amdgcn_rcpf(d.y);
                                if (REGION == 1) { const f2 l = (f2){lb[bj][n][e], lb[bj][n][e + 1]}; o = l + (1.0f - l) * sg; }
                                else o = (a * rs) * sg;
                            }
                            vv[n][e] = o.x; vv[n][e + 1] = o.y;
                        }
                    u32x4 w;
                    if (REGION == 1) {
                        typedef _Float16 h2v __attribute__((ext_vector_type(2)));
                        w.x = __builtin_bit_cast(unsigned, __builtin_convertvector((f2){vv[0][0], vv[0][1]}, h2v)); w.y = __builtin_bit_cast(unsigned, __builtin_convertvector((f2){vv[0][2], vv[0][3]}, h2v));
                        w.z = __builtin_bit_cast(unsigned, __builtin_convertvector((f2){vv[1][0], vv[1][1]}, h2v)); w.w = __builtin_bit_cast(unsigned, __builtin_convertvector((f2){vv[1][2], vv[1][3]}, h2v));
                    } else { w.x = cvt_pk_bf16(vv[0][0], vv[0][1]); w.y = cvt_pk_bf16(vv[0][2], vv[0][3]); w.z = cvt_pk_bf16(vv[1][0], vv[1][1]); w.w = cvt_pk_bf16(vv[1][2], vv[1][3]); }
                    st16(dst + off + bj * HALF, w);
                }
            }
    }
    __device__ __forceinline__ void operator()(const f32x4 (&acc)[2][2][4][2], const Unit& u, int wr, int wc, int fr, int fq) const {
        const int region = u.pn >> 2;
        if (region == 0) body<0>(acc, u, wr, wc, fr, fq); else if (region == 1) body<1>(acc, u, wr, wc, fr, fq); else if (region == 2) body<2>(acc, u, wr, wc, fr, fq); else body<3>(acc, u, wr, wc, fr, fq);
    }
};
template <bool IS_Q> struct EpiHead {
    static constexpr bool PERM = true, AFTER_DRAIN = false;
    bf16_t* O; long off2; const float* gain; const float* rope; const float* ssq; float oscale;
    __device__ __forceinline__ void operator()(const f32x4 (&acc)[2][2][4][2], const Unit& u, int wr, int wc, int fr, int fq) const {
        const int row0 = u.pm * BM + wr * 64 + fr;
        const bool normed = IS_Q || wc < 2;
        float rsv[8]; row_rstd8(ssq, row0, fq, rsv);
        f32x4 gn[2][2];
#pragma unroll
        for (int bj = 0; bj < 2; ++bj)
#pragma unroll
            for (int n = 0; n < 2; ++n) gn[bj][n] = *(const f32x4*)(gain + bj * 32 + 8 * fq + 4 * n);
        bf16_t* dst; int ldo, cbase;
        if (IS_Q) { dst = O; ldo = 1024; cbase = (u.pn * 4 + wc) * 64; } else { dst = O + (wc < 2 ? 0l : off2); ldo = 128; cbase = (wc & 1) * 64; }
#pragma unroll
        for (int ai = 0; ai < 2; ++ai)
#pragma unroll
            for (int m = 0; m < 4; ++m) {
                const int row = row0 + ai * HALF + m * 16; const float rs = rsv[ai * 4 + m];
                f32x4 v[2][2]; float ss = 0.f;
#pragma unroll
                for (int bj = 0; bj < 2; ++bj)
#pragma unroll
                    for (int n = 0; n < 2; ++n) { v[bj][n] = acc[ai][bj][m][n] * rs; ss += (v[bj][n][0] * v[bj][n][0] + v[bj][n][1] * v[bj][n][1]) + (v[bj][n][2] * v[bj][n][2] + v[bj][n][3] * v[bj][n][3]); }
                ss += __shfl_xor(ss, 16); ss += __shfl_xor(ss, 32);
                if (normed) {
                    const float r = 1.0f / sqrtf(ss * (1.0f / 64.0f) + 1e-6f);
#pragma unroll
                    for (int bj = 0; bj < 2; ++bj)
#pragma unroll
                        for (int n = 0; n < 2; ++n) v[bj][n] = v[bj][n] * r * gn[bj][n];
                }
                f32x4 p0, p1;
#pragma unroll
                for (int e = 0; e < 4; ++e) { p0[e] = __shfl_xor(v[0][0][e], 16); p1[e] = __shfl_xor(v[0][1][e], 16); }
                if (normed && fq < 2) {
                    const f32x4* cs = (const f32x4*)(rope + (size_t)(row & 2047) * 16);
                    const f32x4 c0 = cs[0], c1 = cs[1], c2 = cs[2], c3 = cs[3];
                    const float sg = fq == 0 ? -1.0f : 1.0f;
                    v[0][0][0] = v[0][0][0] * c0[0] + sg * p0[0] * c0[1]; v[0][0][1] = v[0][0][1] * c0[2] + sg * p0[1] * c0[3];
                    v[0][0][2] = v[0][0][2] * c1[0] + sg * p0[2] * c1[1]; v[0][0][3] = v[0][0][3] * c1[2] + sg * p0[3] * c1[3];
                    v[0][1][0] = v[0][1][0] * c2[0] + sg * p1[0] * c2[1]; v[0][1][1] = v[0][1][1] * c2[2] + sg * p1[1] * c2[3];
                    v[0][1][2] = v[0][1][2] * c3[0] + sg * p1[2] * c3[1]; v[0][1][3] = v[0][1][3] * c3[2] + sg * p1[3] * c3[3];
                }
                if (!IS_Q && wc >= 2) {
                    const int bb = row >> 11, blk = (row >> 7) & 15, sl = row & 127;
                    bf16_t* vt = O + off2 + ((((size_t)bb * 16 + blk) * 2 + (wc & 1)) * 64) * 128 + sl;
#pragma unroll
                    for (int bj = 0; bj < 2; ++bj)
#pragma unroll
                        for (int n = 0; n < 2; ++n)
#pragma unroll
                            for (int e = 0; e < 4; e += 2) { const unsigned pk = cvt_pk_bf16(v[bj][n][e], v[bj][n][e + 1]); const int d = bj * 32 + 8 * fq + 4 * n + e;
                                vt[(size_t)d * 128] = (bf16_t)(pk & 0xffffu); vt[(size_t)(d + 1) * 128] = (bf16_t)(pk >> 16); }
                } else {
#pragma unroll
                for (int bj = 0; bj < 2; ++bj) {
                    const f32x4 a = v[bj][0] * oscale, b = v[bj][1] * oscale;
                    u32x4 w; w.x = cvt_pk_bf16(a[0], a[1]); w.y = cvt_pk_bf16(a[2], a[3]); w.z = cvt_pk_bf16(b[0], b[1]); w.w = cvt_pk_bf16(b[2], b[3]);
                    st16(dst + (size_t)row * ldo + cbase + bj * 32 + 8 * fq, w);
                }
                }
            }
    }
};

template <class Epi, class Sched, bool ALIGN_EPI = false, bool SP2 = false>
__device__ __forceinline__ void gemm_phase(PG8_LAS unsigned char* lds, const Gemm g, const Sched& S, const Epi& E) {
    const int tid = threadIdx.x, wid = __builtin_amdgcn_readfirstlane(tid >> 6), lane = tid & 63, wr = wid >> 2, wc = wid & 3, fr = lane & 15, fq = lane >> 4;
    const int K = g.K, nt = K / BK;
    unsigned voffA[2], voffB[2];
#pragma unroll
    for (int i = 0; i < 2; ++i) { int R, C; stage_rc(tid * 16 + i * 8192, R, C); const int Rb = Epi::PERM ? ((R & ~31) + perm32(R & 31)) : R;
        voffA[i] = (unsigned)(R * K + C) * 2u; voffB[i] = (unsigned)(Rb * K + C) * 2u; }
    const size_t kstep = (size_t)(BK * 2);
    const size_t hstep = (size_t)HALF * K * 2;
    const size_t tstep = 2 * hstep;
    const unsigned ldsw = (unsigned)wid * 1024u;
    const int aoff = lds_byte(wr * 64 + fr, fq * 8), boff = lds_byte(wc * 32 + fr, fq * 8);
#define PG8_SA(b, h) (((b) * 2 + (h)) * HTB)
#define PG8_SB(b, h) ((4 + (b) * 2 + (h)) * HTB)
#define PG8_STAGE(bufoff, gbase, voff) do { _Pragma("unroll") for (int _i = 0; _i < 2; ++_i) \
        __builtin_amdgcn_global_load_lds((const unsigned*)((const char*)(gbase) + (voff)[_i]), (PG8_LAS unsigned*)(lds + (bufoff) + ldsw + _i * 8192), 16, 0, 0); } while (0)
#define PG8_LDA(dst, b, h) do { _Pragma("unroll") for (int m = 0; m < 4; ++m) _Pragma("unroll") for (int k = 0; k < 2; ++k) dst[m][k] = *(const PG8_LAS bf16x8*)(lds + PG8_SA(b, h) + aoff + m * 2048 + k * 1024); } while (0)
#define PG8_LDB(dst, b, h) do { _Pragma("unroll") for (int n = 0; n < 2; ++n) _Pragma("unroll") for (int k = 0; k < 2; ++k) dst[n][k] = *(const PG8_LAS bf16x8*)(lds + PG8_SB(b, h) + boff + n * 2048 + k * 1024); } while (0)
#define PG8_MMA(ai, bj, At, Bt) do { __builtin_amdgcn_s_setprio(1); _Pragma("unroll") for (int m = 0; m < 4; ++m) _Pragma("unroll") for (int n = 0; n < 2; ++n) _Pragma("unroll") for (int k = 0; k < 2; ++k) \
        acc[ai][bj][m][n] = __builtin_amdgcn_mfma_f32_16x16x32_bf16(Bt[n][k], At[m][k], acc[ai][bj][m][n], 0, 0, 0); __builtin_amdgcn_s_setprio(0); } while (0)
#define PG8_WAIT_V(n) asm volatile("s_waitcnt vmcnt(" #n ")" ::: "memory")
#define PG8_WAIT_L(n) asm volatile("s_waitcnt lgkmcnt(" #n ")" ::: "memory")
#define PG8_BAR __builtin_amdgcn_s_barrier()
#define PG8_SCHED __builtin_amdgcn_sched_barrier(0)
    Unit cur, nxt; int ui = 0;
    if (!S.next(0, cur)) return;
    f32x4 acc[2][2][4][2];
#pragma unroll
    for (int a = 0; a < 2; ++a)
#pragma unroll
        for (int b = 0; b < 2; ++b)
#pragma unroll
            for (int m = 0; m < 4; ++m)
#pragma unroll
                for (int n = 0; n < 2; ++n) acc[a][b][m][n] = (f32x4){0.f, 0.f, 0.f, 0.f};
    bf16x8 At[4][2], B0[2][2], B1[2][2];
    const char* cA = (const char*)g.A + (size_t)cur.pm * tstep; const char* cB = (const char*)g.Bt + (size_t)cur.pn * tstep;
    S.a_ready(cur);
    if constexpr (SP2) {
        PG8_STAGE(PG8_SB(0, 0), cB, voffB); PG8_STAGE(PG8_SB(0, 1), cB + hstep, voffB); PG8_STAGE(PG8_SA(0, 0), cA, voffA); PG8_STAGE(PG8_SA(0, 1), cA + hstep, voffA);
        if (wr == 1) PG8_BAR;
        PG8_WAIT_V(2); PG8_BAR;
        PG8_STAGE(PG8_SB(1, 0), cB + kstep, voffB); PG8_STAGE(PG8_SA(1, 0), cA + kstep, voffA); PG8_STAGE(PG8_SB(1, 1), cB + hstep + kstep, voffB);
        PG8_WAIT_V(6); PG8_BAR;
    } else {
        PG8_STAGE(PG8_SB(0, 0), cB, voffB); PG8_STAGE(PG8_SA(0, 0), cA, voffA); PG8_STAGE(PG8_SB(0, 1), cB + hstep, voffB); PG8_STAGE(PG8_SA(0, 1), cA + hstep, voffA);
        if (wr == 1) PG8_BAR;
        PG8_WAIT_V(4); PG8_BAR;
        PG8_STAGE(PG8_SB(1, 0), cB + kstep, voffB); PG8_STAGE(PG8_SA(1, 0), cA + kstep, voffA); PG8_STAGE(PG8_SB(1, 1), cB + hstep + kstep, voffB);
        PG8_WAIT_V(6); PG8_BAR;
    }
    for (;;) {
        const bool has_next = S.next(ui + 1, nxt);
        const char* nA = has_next ? (const char*)g.A + (size_t)nxt.pm * tstep : cA; const char* nB = has_next ? (const char*)g.Bt + (size_t)nxt.pn * tstep : cB;
        for (int t = 0; t < nt; t += 2) {
            const bool last = (t == nt - 2);
            const char* a1 = cA + (size_t)(t + 1) * kstep;
            const char* a2 = last ? nA : cA + (size_t)(t + 2) * kstep; const char* b2 = last ? nB : cB + (size_t)(t + 2) * kstep;
            const char* a3 = a2 + kstep; const char* b3 = b2 + kstep;
            if (last && has_next) S.a_ready(nxt);
            if constexpr (SP2) {
            PG8_LDB(B0, 0, 0); PG8_LDB(B1, 0, 1); PG8_SCHED; PG8_LDA(At, 0, 0); PG8_STAGE(PG8_SA(1, 1), a1 + hstep, voffA);
            PG8_WAIT_V(8); PG8_WAIT_L(0); PG8_BAR; PG8_MMA(0, 0, At, B0); PG8_MMA(0, 1, At, B1); PG8_BAR; PG8_SCHED;
            PG8_LDA(At, 0, 1); PG8_STAGE(PG8_SB(0, 0), b2, voffB); PG8_STAGE(PG8_SB(0, 1), b2 + hstep, voffB); PG8_STAGE(PG8_SA(0, 0), a2, voffA);
            PG8_WAIT_V(8); PG8_WAIT_L(0); PG8_BAR; PG8_MMA(1, 0, At, B0); PG8_MMA(1, 1, At, B1); PG8_BAR; PG8_SCHED;
            PG8_LDB(B0, 1, 0); PG8_LDB(B1, 1, 1); PG8_SCHED; PG8_LDA(At, 1, 0); PG8_STAGE(PG8_SA(0, 1), a2 + hstep, voffA);
            PG8_WAIT_V(8); PG8_WAIT_L(0); PG8_BAR; PG8_MMA(0, 0, At, B0); PG8_MMA(0, 1, At, B1); PG8_BAR; PG8_SCHED;
            PG8_LDA(At, 1, 1); PG8_STAGE(PG8_SB(1, 0), b3, voffB); PG8_STAGE(PG8_SB(1, 1), b3 + hstep, voffB); PG8_STAGE(PG8_SA(1, 0), a3, voffA);
            PG8_WAIT_V(8); PG8_WAIT_L(0); PG8_BAR; PG8_MMA(1, 0, At, B0); PG8_MMA(1, 1, At, B1); PG8_BAR; PG8_SCHED;
            } else {
            PG8_LDB(B0, 0, 0); PG8_SCHED; PG8_LDA(At, 0, 0); PG8_STAGE(PG8_SA(1, 1), a1 + hstep, voffA);
            PG8_WAIT_L(8); PG8_BAR; PG8_WAIT_L(0); PG8_MMA(0, 0, At, B0); PG8_BAR; PG8_SCHED;
            PG8_LDB(B1, 0, 1); PG8_STAGE(PG8_SB(0, 0), b2, voffB);
            PG8_BAR; PG8_WAIT_L(0); PG8_MMA(0, 1, At, B1); PG8_BAR;
            PG8_LDA(At, 0, 1); PG8_STAGE(PG8_SA(0, 0), a2, voffA);
            PG8_BAR; PG8_WAIT_L(0); PG8_MMA(1, 0, At, B0); PG8_BAR; PG8_SCHED;
            PG8_STAGE(PG8_SB(0, 1), b2 + hstep, voffB);
            PG8_WAIT_V(6); PG8_BAR; PG8_MMA(1, 1, At, B1); PG8_BAR;
            PG8_LDB(B0, 1, 0); PG8_SCHED; PG8_LDA(At, 1, 0); PG8_STAGE(PG8_SA(0, 1), a2 + hstep, voffA);
            PG8_WAIT_L(8); PG8_BAR; PG8_WAIT_L(0); PG8_MMA(0, 0, At, B0); PG8_BAR; PG8_SCHED;
            PG8_LDB(B1, 1, 1); PG8_STAGE(PG8_SB(1, 0), b3, voffB);
            PG8_BAR; PG8_WAIT_L(0); PG8_MMA(0, 1, At, B1); PG8_BAR;
            PG8_LDA(At, 1, 1); PG8_STAGE(PG8_SA(1, 0), a3, voffA);
            PG8_BAR; PG8_WAIT_L(0); PG8_MMA(1, 0, At, B0); PG8_BAR; PG8_SCHED;
            PG8_STAGE(PG8_SB(1, 1), b3 + hstep, voffB);
            PG8_WAIT_V(6); PG8_BAR; PG8_MMA(1, 1, At, B1); PG8_BAR;
            }
        }
        if constexpr (ALIGN_EPI) { if (wr == 0) PG8_BAR; }
        if constexpr (!Epi::AFTER_DRAIN) { E(acc, cur, wr, wc, fr, fq); S.done(cur); }
        if (!has_next) break;
#pragma unroll
        for (int a = 0; a < 2; ++a)
#pragma unroll
            for (int b = 0; b < 2; ++b)
#pragma unroll
                for (int m = 0; m < 4; ++m)
#pragma unroll
                    for (int n = 0; n < 2; ++n) acc[a][b][m][n] = (f32x4){0.f, 0.f, 0.f, 0.f};
        cur = nxt; cA = nA; cB = nB; ++ui;
        if constexpr (ALIGN_EPI) { if (wr == 1) PG8_BAR; }
    }
    PG8_WAIT_V(0);
    if constexpr (!ALIGN_EPI) { if (wr == 0) PG8_BAR; }
    PG8_BAR;
    if constexpr (Epi::AFTER_DRAIN) { E.fused(acc, cur, wr, wc, fr, fq, lds, wid, lane); S.done(cur); }
#undef PG8_SA
#undef PG8_SB
#undef PG8_STAGE
#undef PG8_LDA
#undef PG8_LDB
#undef PG8_MMA
#undef PG8_WAIT_V
#undef PG8_WAIT_L
#undef PG8_BAR
#undef PG8_SCHED
}
}
#define LAS __attribute__((address_space(3)))
#define XB_TMO      128
#define XB_XCNT(j)  (256  + 64 * (j))
#define XB_XSUB(j)  (1280 + 64 * (j))
#define XB_XGEN(j)  (2304 + 64 * (j))
#define XB_TOP      3328
#define XB_TOPGEN   3392
#define XCD_BAR_WORDS 3456
#define XB_SPIN_CAP (1u << 18)

__device__ __forceinline__ unsigned xb_ld(unsigned* p)              { return __hip_atomic_load(p, __ATOMIC_RELAXED, __HIP_MEMORY_SCOPE_AGENT); }
__device__ __forceinline__ unsigned xb_add(unsigned* p, unsigned v) { return __hip_atomic_fetch_add(p, v, __ATOMIC_RELAXED, __HIP_MEMORY_SCOPE_AGENT); }
__device__ __forceinline__ unsigned xb_xcc_id() { return (unsigned)__builtin_amdgcn_s_getreg((3 << 11) | 20) & 0xFu; }
#define XB_SPIN(cond, bar) do { unsigned _sp = 0; while (cond) { __builtin_amdgcn_s_sleep(1); \
    if ((++_sp & 255u) == 0u) { if (xb_ld(&(bar)[XB_TMO])) break; if (_sp > XB_SPIN_CAP) { atomicAdd(&(bar)[XB_TMO], 1u); break; } } } } while (0)

struct XcdBarrier {
    unsigned* bar; unsigned x;
    volatile LAS unsigned* st;
};

__device__ __forceinline__ XcdBarrier xcd_barrier_post(unsigned* bar, volatile LAS unsigned* st) {
    XcdBarrier b; b.bar = bar; b.x = xb_xcc_id(); b.st = st;
    if (threadIdx.x == 0) (void)xb_add(&bar[XB_XCNT(b.x)], 1u);
    return b;
}
__device__ __forceinline__ void xcd_barrier_complete(unsigned* bar, unsigned x, unsigned& nloc, unsigned& nx) {
    const unsigned G = gridDim.x * gridDim.y * gridDim.z;
    unsigned sum, cnt, mine, sp = 0u;
    for (;;) {
        sum = 0u; cnt = 0u; mine = 0u;
#pragma unroll
        for (unsigned j = 0; j < 16; ++j) { const unsigned c = xb_ld(&bar[XB_XCNT(j)]); sum += c; cnt += (c > 0u) ? 1u : 0u; mine = (j == x) ? c : mine; }
        if (sum == G) break;
        __builtin_amdgcn_s_sleep(1);
        if ((++sp & 255u) == 0u) { if (xb_ld(&bar[XB_TMO])) break; if (sp > XB_SPIN_CAP) { atomicAdd(&bar[XB_TMO], 1u); break; } }
    }
    nloc = mine > 0u ? mine : 1u; nx = cnt > 0u ? cnt : 1u;
}

__device__ __forceinline__ void xcd_barrier(const XcdBarrier& b) {
    asm volatile("s_waitcnt vmcnt(0)" ::: "memory");
    __syncthreads();
    if (threadIdx.x == 0) {
        unsigned* bar = b.bar;
        __builtin_amdgcn_s_waitcnt(0);
        unsigned nloc = b.st[0], nx = b.st[1];
        if (nloc == 0u) { xcd_barrier_complete(bar, b.x, nloc, nx); b.st[0] = nloc; b.st[1] = nx; }
        const unsigned old = xb_add(&bar[XB_XSUB(b.x)], 1u);
        const unsigned gen = old / nloc;
        if (old + 1u == (gen + 1u) * nloc) {
            __builtin_amdgcn_fence(__ATOMIC_RELEASE, "agent");
            asm volatile("s_waitcnt vmcnt(0)" ::: "memory");
            const unsigned og = xb_add(&bar[XB_TOP], 1u);
            const unsigned tg = og / nx;
            if (og + 1u == (tg + 1u) * nx) xb_add(&bar[XB_TOPGEN], 1u);
            else XB_SPIN(xb_ld(&bar[XB_TOPGEN]) == tg, bar);
            __builtin_amdgcn_fence(__ATOMIC_ACQUIRE, "agent");
            xb_add(&bar[XB_XGEN(b.x)], 1u);
            asm volatile("s_waitcnt vmcnt(0)" ::: "memory");
        } else {
            XB_SPIN(xb_ld(&bar[XB_XGEN(b.x)]) == gen, bar);
            __builtin_amdgcn_fence(__ATOMIC_ACQUIRE, "agent");
            asm volatile("s_waitcnt vmcnt(0)" ::: "memory");
        }
    }
    __syncthreads();
}

#define XL_CNT(j)  (3584 + 64 * (j))
__device__ __forceinline__ void xcd_local_barrier(unsigned* bar, unsigned x, unsigned nloc) {
    asm volatile("s_waitcnt vmcnt(0)" ::: "memory");
    __syncthreads();
    if (threadIdx.x == 0) {
        __builtin_amdgcn_s_waitcnt(0);
        const unsigned old = xb_add(&bar[XL_CNT(x)], 1u);
        const unsigned target = (old / nloc + 1u) * nloc;
        XB_SPIN(xb_ld(&bar[XL_CNT(x)]) < target, bar);
        __builtin_amdgcn_fence(__ATOMIC_ACQUIRE, "agent");
        asm volatile("s_waitcnt vmcnt(0)" ::: "memory");
    }
    __syncthreads();
}

constexpr int NWAVES = 8;
constexpr int BATCH = 16, SEQ = 2048, D = 1024, FF = 2816, M = BATCH * SEQ;
constexpr int HG_HEADS = 8, HG_DK = 128, HG_CHUNK = 64, NCHUNK = SEQ / HG_CHUNK;
constexpr int ATT_HEADS = 16, ATT_KVH = 2, ATT_HD = 64, WINDOW = 128, NBLK = SEQ / WINDOW;
constexpr float EPS = 1e-6f;

#ifndef PROBE_DUP
#define PROBE_DUP 0
#endif
#ifndef MK_ONE_LAUNCH
#define MK_ONE_LAUNCH 1
#endif

constexpr size_t MiB = 1u << 20;
constexpr size_t SZ_WGU = (size_t)2 * FF * D * 2, SZ_WD = (size_t)D * FF * 2;
constexpr size_t WS_MISC = 0;
constexpr size_t WS_BAR = 512 * 1024, BAR_BYTES = 16384;
constexpr size_t WS_WGU = 1 * MiB;
constexpr size_t WS_WD = WS_WGU + 4 * SZ_WGU;
constexpr size_t WS_WIN = WS_WD + 4 * SZ_WD;
constexpr size_t WS_WHO = WS_WIN + (size_t)4096 * D * 2;
constexpr size_t WS_WKV = WS_WHO + (size_t)D * D * 2;
constexpr size_t WS_WQ = WS_WKV + (size_t)256 * D * 2;
constexpr size_t WS_WAO = WS_WQ + (size_t)D * D * 2;
constexpr size_t WS_WEND = WS_WAO + (size_t)D * D * 2;
constexpr size_t WS_HB = 88 * MiB;
constexpr size_t WS_SSQ = WS_HB + 64 * MiB;
constexpr size_t WS_KB = WS_SSQ + 2 * MiB;
constexpr size_t WS_VB = WS_KB + 8 * MiB;
constexpr size_t WS_R = WS_VB + 8 * MiB;
constexpr size_t WS_ACT = WS_R;
constexpr size_t WS_HQ = WS_R, WS_HLOGF = WS_R + 64 * MiB, WS_HV = WS_R + 192 * MiB, WS_HG = WS_R + 256 * MiB;
constexpr size_t WS_QA = WS_R + 192 * MiB;
constexpr size_t WS_END = WS_R + 320 * MiB;
static_assert(WS_WEND <= WS_HB && (size_t)M * FF * 2 <= 320 * MiB && WS_END <= 512 * MiB, "d_ws map");

constexpr int LDS_BYTES = 147456;

typedef unsigned short bf16;
typedef unsigned v4u __attribute__((ext_vector_type(4)));
typedef unsigned v2u __attribute__((ext_vector_type(2)));
typedef float f32x4 __attribute__((ext_vector_type(4)));
typedef float f32x16 __attribute__((ext_vector_type(16)));
typedef short bf16x8 __attribute__((ext_vector_type(8)));
#define LDS_WAIT() asm volatile("s_waitcnt lgkmcnt(0)" ::: "memory")
__device__ __forceinline__ unsigned f2bf(float f) { unsigned u = __builtin_bit_cast(unsigned, f); return (u + 0x7fffu + ((u >> 16) & 1u)) >> 16; }
__device__ __forceinline__ unsigned pk2(float lo, float hi) { return pg8::cvt_pk_bf16(lo, hi); }
__device__ __forceinline__ float bf2f(unsigned short b) { return __builtin_bit_cast(float, (unsigned)b << 16); }
__device__ __forceinline__ float wave_sum(float v) {
#pragma unroll
    for (int o = 1; o < 64; o <<= 1) v += __shfl_xor(v, o);
    return v;
}

template <int MODE> __device__ __forceinline__ int remap_row(int n) {
    if (MODE == 1) { const int bj = n >= FF ? 1 : 0, r = n - bj * FF, t = r >> 7, j = r & 127; return 256 * t + 128 * bj + j; }
    if (MODE == 2) { const int head = n >> 6, d = n & 63, pn = head >> 2, wc = head & 3, bj = d >> 5, j = d & 31; return 256 * pn + 128 * bj + 32 * wc + j; }
    return n;
}
struct Args {
    const float* x; const float* ffn_norm_g; const float* ffn_w_gate_up; const float* ffn_w_down; const float* mix_norm_g; const float* hgrn_w_in; const float* hgrn_lb_logits;
    const float* hgrn_onorm_g; const float* hgrn_w_out; const float* kv_norm_g; const float* kv_w; const float* k_norm_g; const float* attn_w_q; const float* q_norm_g;
    const float* attn_sinks; const float* attn_w_out;
    float* out; unsigned char* ws; int ph_lo, ph_hi;
};

struct TItem { const float* W; const float* gk; bf16* WT; int K, N, mode, k0, n0; };
__device__ __forceinline__ int remap_rt(int mode, int n) { return mode == 1 ? remap_row<1>(n) : (mode == 2 ? remap_row<2>(n) : n); }
template <int SET> __device__ __forceinline__ TItem titem(const Args& a, int it) {
    unsigned char* ws = a.ws; TItem t; int r = it;
    constexpr int I_GU = (D / 64) * (2 * FF / 32), I_D = (FF / 64) * (D / 32), I_IN = (D / 64) * (4096 / 32), I_SQ = (D / 64) * (D / 32), I_KV = (D / 64) * (256 / 32);
    if (SET == 0) {
        if (r < I_GU) { t.W = a.ffn_w_gate_up; t.gk = a.ffn_norm_g; t.WT = (bf16*)(ws + WS_WGU); t.K = D; t.N = 2 * FF; t.mode = 1; }
        else if ((r -= I_GU) < I_D) { t.W = a.ffn_w_down; t.gk = nullptr; t.WT = (bf16*)(ws + WS_WD); t.K = FF; t.N = D; t.mode = 0; }
        else if ((r -= I_D) < I_IN) { t.W = a.hgrn_w_in; t.gk = a.mix_norm_g; t.WT = (bf16*)(ws + WS_WIN); t.K = D; t.N = 4096; t.mode = 0; }
        else { r -= I_IN; t.W = a.hgrn_w_out; t.gk = nullptr; t.WT = (bf16*)(ws + WS_WHO); t.K = D; t.N = D; t.mode = 0; }
    } else {
        if (r < 3 * I_GU) { const int l = 1 + r / I_GU; r -= (l - 1) * I_GU; t.W = a.ffn_w_gate_up + (size_t)l * D * 2 * FF; t.gk = a.ffn_norm_g + l * D; t.WT = (bf16*)(ws + WS_WGU + l * SZ_WGU); t.K = D; t.N = 2 * FF; t.mode = 1; }
        else if ((r -= 3 * I_GU) < 3 * I_D) { const int l = 1 + r / I_D; r -= (l - 1) * I_D; t.W = a.ffn_w_down + (size_t)l * FF * D; t.gk = nullptr; t.WT = (bf16*)(ws + WS_WD + l * SZ_WD); t.K = FF; t.N = D; t.mode = 0; }
        else if ((r -= 3 * I_D) < I_KV) { t.W = a.kv_w; t.gk = a.kv_norm_g; t.WT = (bf16*)(ws + WS_WKV); t.K = D; t.N = 256; t.mode = 2; }
        else if ((r -= I_KV) < I_SQ) { t.W = a.attn_w_q; t.gk = a.mix_norm_g + D; t.WT = (bf16*)(ws + WS_WQ); t.K = D; t.N = D; t.mode = 2; }
        else { r -= I_SQ; t.W = a.attn_w_out; t.gk = nullptr; t.WT = (bf16*)(ws + WS_WAO); t.K = D; t.N = D; t.mode = 0; }
    }
    const int nblk = t.N / 32, kb = r / nblk, nb = r - kb * nblk; t.k0 = 64 * kb; t.n0 = 32 * nb;
    return t;
}
struct TRegs { float r[32]; f32x4 g0, g1; };
__device__ __forceinline__ void tload(const TItem& t, int lane, TRegs& q) {
    const float* p = t.W + (size_t)(t.k0 + (lane >> 5)) * t.N + t.n0 + (lane & 31);
#pragma unroll
    for (int i = 0; i < 32; ++i) q.r[i] = p[(size_t)(2 * i) * t.N];
    if (t.gk) { q.g0 = *(const f32x4*)(t.gk + t.k0 + 8 * (lane & 7)); q.g1 = *(const f32x4*)(t.gk + t.k0 + 8 * (lane & 7) + 4); }
    else { q.g0 = (f32x4){1.f, 1.f, 1.f, 1.f}; q.g1 = q.g0; }
}
__device__ __forceinline__ void tfinish(const TItem& t, LAS float* scr, int lane, const TRegs& q) {
#pragma unroll
    for (int i = 0; i < 32; ++i) scr[(2 * i + (lane >> 5)) * 33 + (lane & 31)] = q.r[i];
    LDS_WAIT(); asm volatile("" ::: "memory");
    const int c = lane & 7;
#pragma unroll
    for (int j = 0; j < 4; ++j) { const int n = (lane >> 3) + 8 * j; const LAS float* s = scr + (8 * c) * 33 + n;
        v4u o; o.x = pk2(s[0 * 33] * q.g0[0], s[1 * 33] * q.g0[1]); o.y = pk2(s[2 * 33] * q.g0[2], s[3 * 33] * q.g0[3]); o.z = pk2(s[4 * 33] * q.g1[0], s[5 * 33] * q.g1[1]); o.w = pk2(s[6 * 33] * q.g1[2], s[7 * 33] * q.g1[3]);
        *(v4u*)(t.WT + (size_t)remap_rt(t.mode, t.n0 + n) * t.K + t.k0 + 8 * c) = o; }
    LDS_WAIT(); asm volatile("" ::: "memory");
}
template <int SET> __device__ __forceinline__ void p0_transposes(const Args& a, LAS unsigned char* lds, int widx, int nw, int wave, int lane) {
    LAS float* scr = (LAS float*)(lds + wave * 16384);
    const int gw = widx * NWAVES + wave, NGW = nw * NWAVES;
    constexpr int I_GU = (D / 64) * (2 * FF / 32), I_D = (FF / 64) * (D / 32), I_IN = (D / 64) * (4096 / 32), I_SQ = (D / 64) * (D / 32), I_KV = (D / 64) * (256 / 32);
    constexpr int NITEMS = SET == 0 ? I_GU + I_D + I_IN + I_SQ : 3 * I_GU + 3 * I_D + 2 * I_SQ + I_KV;
    int it = gw; if (it >= NITEMS) return;
    TItem ta = titem<SET>(a, it), tb = ta; TRegs ra, rb;
    tload(ta, lane, ra);
    for (;;) {
        const int i1 = it + NGW; const bool h1 = i1 < NITEMS;
        if (h1) { tb = titem<SET>(a, i1); tload(tb, lane, rb); }
        tfinish(ta, scr, lane, ra);
        if (!h1) break;
        const int i2 = i1 + NGW; const bool h2 = i2 < NITEMS;
        if (h2) { ta = titem<SET>(a, i2); tload(ta, lane, ra); }
        tfinish(tb, scr, lane, rb);
        if (!h2) break;
        it = i2;
    }
}
__device__ __forceinline__ void p0_prologue(const Args& a, LAS unsigned char* lds, int bid, int G, int wave, int lane) {
    p0_transposes<0>(a, lds, bid, G, wave, lane);
    const int gw = bid * NWAVES + wave, NGW = G * NWAVES;
    unsigned char* ws = a.ws;
    bf16* hb = (bf16*)(ws + WS_HB); float* ssq = (float*)(ws + WS_SSQ);
    for (int m = gw; m < M; m += 2 * NGW) {
        const int m2 = m + NGW;
        const bool has2 = m2 < M;
        const f32x4* xr = (const f32x4*)(a.x + (size_t)m * D) + lane; const f32x4* xr2 = (const f32x4*)(a.x + (size_t)(has2 ? m2 : m) * D) + lane;
        f32x4 v[4], v2[4]; float s = 0.f, s2 = 0.f;
#pragma unroll
        for (int j = 0; j < 4; ++j) { v[j] = xr[64 * j]; v2[j] = xr2[64 * j]; }
#pragma unroll
        for (int j = 0; j < 4; ++j) { s += (v[j].x * v[j].x + v[j].y * v[j].y) + (v[j].z * v[j].z + v[j].w * v[j].w); s2 += (v2[j].x * v2[j].x + v2[j].y * v2[j].y) + (v2[j].z * v2[j].z + v2[j].w * v2[j].w); }
        s = wave_sum(s); s2 = wave_sum(s2);
        unsigned long long* o8 = (unsigned long long*)(hb + (size_t)m * D) + lane;
#pragma unroll
        for (int j = 0; j < 4; ++j) o8[64 * j] = (unsigned long long)pk2(v[j].x, v[j].y) | ((unsigned long long)pk2(v[j].z, v[j].w) << 32);
        if (lane < 16) ssq[(size_t)m * 16 + lane] = lane == 0 ? s : 0.f;
        if (has2) {
            unsigned long long* o82 = (unsigned long long*)(hb + (size_t)m2 * D) + lane;
#pragma unroll
            for (int j = 0; j < 4; ++j) o82[64 * j] = (unsigned long long)pk2(v2[j].x, v2[j].y) | ((unsigned long long)pk2(v2[j].z, v2[j].w) << 32);
            if (lane < 16) ssq[(size_t)m2 * 16 + lane] = lane == 0 ? s2 : 0.f;
        }
    }
    float* lbv = (float*)(ws + WS_MISC); float* rope = (float*)(ws + WS_MISC + 65536);
    for (int i = gw * 64 + lane; i < 1024; i += NGW * 64) { const float l0 = a.hgrn_lb_logits[i], l1 = a.hgrn_lb_logits[1024 + i]; lbv[i] = 1.0f / (1.0f + expf(l1 - l0)); }
    for (int i = gw * 64 + lane; i < 2048 * 8; i += NGW * 64) { const int pos = i >> 3, k = i & 7;
        const float inv_freq = powf(500000.0f, -(float)k * 0.125f); const float ang = (float)pos * inv_freq;
        rope[2 * i] = cosf(ang); rope[2 * i + 1] = sinf(ang); }
}

constexpr int HQE = 0, HKE = 17408, HKDT = 34816, HVT = 53248, HSC = 71680, HBEND = 80896, HCUM = 81408, HNRM = 85504;
constexpr int PQ = 272, PT = 144;
typedef float f32x2 __attribute__((ext_vector_type(2)));
typedef _Float16 h2v __attribute__((ext_vector_type(2)));
__device__ __forceinline__ void hgrn_phase(LAS unsigned char* lds, const bf16* qb, const float* fgt, const bf16* vb, const bf16* gb, bf16* og, const float* onorm_g, int G, int bid, int tid, int w, int lane, unsigned* xbar = nullptr, unsigned xcc_ = 0u, int midc = -1) {
    const int g = lane >> 4, lr = lane & 15;
    const int cp = lane, grp = w;
#define HG_FINALIZE(ROW0) do { \
        _Pragma("unroll") for (int t4 = 0; t4 < 4; ++t4) { const int t = 16 * t4 + lr; const f32x4 na = *(const LAS f32x4*)(lds + HNRM + t * 32), nb = *(const LAS f32x4*)(lds + HNRM + t * 32 + 16); \
            const float tot2 = ((na[0] + na[1]) + (na[2] + na[3])) + ((nb[0] + nb[1]) + (nb[2] + nb[3])); const float r = 1.0f / sqrtf(tot2 * (1.0f / 128.0f) + EPS); \
            const float g0 = bf2f((unsigned short)(gt[t4].x & 0xffffu)), g1 = bf2f((unsigned short)(gt[t4].x >> 16)), g2 = bf2f((unsigned short)(gt[t4].y & 0xffffu)), g3 = bf2f((unsigned short)(gt[t4].y >> 16)); \
            v2u ov; ov.x = pk2(o[t4][0] * r * gnv[0] * g0, o[t4][1] * r * gnv[1] * g1); ov.y = pk2(o[t4][2] * r * gnv[2] * g2, o[t4][3] * r * gnv[3] * g3); \
            *(v2u*)(og + ((ROW0) + t) * 1024 + colbase + 16 * w + 4 * g) = ov; } } while (0)
    for (int item = bid; item < BATCH * HG_HEADS; item += G) {
        const int b = item >> 3, head = item & 7, colbase = head * 128;
        const size_t rbase = (size_t)b * SEQ;
        f32x4 S[8];
#pragma unroll
        for (int j = 0; j < 8; ++j) S[j] = (f32x4){0.f, 0.f, 0.f, 0.f};
        const f32x4 gnv = *(const f32x4*)(onorm_g + 16 * w + 4 * g);
        f32x2 nf[8]; unsigned nq[8], nv[8];
        { const size_t base = (rbase + 8 * grp) * 1024 + colbase + 2 * cp;
#pragma unroll
          for (int i = 0; i < 8; ++i) { nf[i] = __builtin_convertvector(*(const h2v*)((const _Float16*)fgt + base + (size_t)i * 1024), f32x2); nq[i] = *(const unsigned*)(qb + base + (size_t)i * 1024); nv[i] = *(const unsigned*)(vb + base + (size_t)i * 1024); } }
        f32x4 o[4]; v2u gt[4];
#pragma unroll
        for (int t4 = 0; t4 < 4; ++t4) { o[t4] = (f32x4){0.f, 0.f, 0.f, 0.f}; gt[t4] = (v2u){0u, 0u}; }
        for (int c = 0; c < NCHUNK; ++c) {
            if (c == midc) xcd_local_barrier(xbar, xcc_, 32u);
            const size_t row0 = rbase + c * HG_CHUNK;
            f32x2 P[8]; { float p0 = 1.f, p1 = 1.f;
#pragma unroll
              for (int i = 0; i < 8; ++i) { p0 *= nf[i].x; p1 *= nf[i].y; P[i] = (f32x2){p0, p1}; }
              *(LAS f32x2*)(lds + HCUM + (grp * 128 + 2 * cp) * 4) = (f32x2){p0, p1}; }
            LDS_WAIT(); __builtin_amdgcn_s_barrier(); asm volatile("" ::: "memory");
            float pre0 = 1.f, pre1 = 1.f, tot0 = 1.f, tot1 = 1.f;
#pragma unroll
            for (int gg = 0; gg < 8; ++gg) { const f32x2 t = *(const LAS f32x2*)(lds + HCUM + (gg * 128 + 2 * cp) * 4); if (gg < grp) { pre0 *= t.x; pre1 *= t.y; } tot0 *= t.x; tot1 *= t.y; }
            float kd0[8], kd1[8];
#pragma unroll
            for (int i = 0; i < 8; ++i) {
                const float eb0 = pre0 * P[i].x, eb1 = pre1 * P[i].y, k0 = 1.0f - nf[i].x, k1 = 1.0f - nf[i].y;
                const float q0 = bf2f((unsigned short)(nq[i] & 0xffffu)), q1 = bf2f((unsigned short)(nq[i] >> 16));
                const float ke0 = k0 * __builtin_amdgcn_rcpf(eb0), ke1 = k1 * __builtin_amdgcn_rcpf(eb1);
                const int s = 8 * grp + i;
                *(LAS unsigned*)(lds + HQE + s * PQ + cp * 4) = pk2(q0 * eb0, q1 * eb1);
                *(LAS unsigned*)(lds + HKE + s * PQ + cp * 4) = pk2(ke0, ke1);
                kd0[i] = ke0 * tot0; kd1[i] = ke1 * tot1;
            }
            { v4u a, bq, va, vq;
              a.x = pk2(kd0[0], kd0[1]); a.y = pk2(kd0[2], kd0[3]); a.z = pk2(kd0[4], kd0[5]); a.w = pk2(kd0[6], kd0[7]);
              bq.x = pk2(kd1[0], kd1[1]); bq.y = pk2(kd1[2], kd1[3]); bq.z = pk2(kd1[4], kd1[5]); bq.w = pk2(kd1[6], kd1[7]);
              va.x = (nv[0] & 0xffffu) | (nv[1] << 16); va.y = (nv[2] & 0xffffu) | (nv[3] << 16); va.z = (nv[4] & 0xffffu) | (nv[5] << 16); va.w = (nv[6] & 0xffffu) | (nv[7] << 16);
              vq.x = (nv[0] >> 16) | (nv[1] & 0xffff0000u); vq.y = (nv[2] >> 16) | (nv[3] & 0xffff0000u); vq.z = (nv[4] >> 16) | (nv[5] & 0xffff0000u); vq.w = (nv[6] >> 16) | (nv[7] & 0xffff0000u);
              *(LAS v4u*)(lds + HKDT + (2 * cp) * PT + grp * 16) = a; *(LAS v4u*)(lds + HKDT + (2 * cp + 1) * PT + grp * 16) = bq;
              *(LAS v4u*)(lds + HVT + (2 * cp) * PT + grp * 16) = va; *(LAS v4u*)(lds + HVT + (2 * cp + 1) * PT + grp * 16) = vq; }
            if (grp == 0) *(LAS f32x2*)(lds + HBEND + 2 * cp * 4) = (f32x2){tot0, tot1};
            LDS_WAIT(); __builtin_amdgcn_s_barrier(); asm volatile("" ::: "memory");
            if (c > 0) HG_FINALIZE(row0 - HG_CHUNK);
            __builtin_amdgcn_sched_barrier(0);
            if (c + 1 < NCHUNK) { const size_t base = (row0 + HG_CHUNK + 8 * grp) * 1024 + colbase + 2 * cp;
#pragma unroll
              for (int i = 0; i < 8; ++i) { nf[i] = __builtin_convertvector(*(const h2v*)((const _Float16*)fgt + base + (size_t)i * 1024), f32x2); nq[i] = *(const unsigned*)(qb + base + (size_t)i * 1024); nv[i] = *(const unsigned*)(vb + base + (size_t)i * 1024); } }
#pragma unroll
            for (int t4 = 0; t4 < 4; ++t4) gt[t4] = *(const v2u*)(gb + (row0 + 16 * t4 + lr) * 1024 + colbase + 16 * w + 4 * g);
            __builtin_amdgcn_sched_barrier(0);
            { const int tt = w >> 1; const int st0 = 2 * (w & 1);
              bf16x8 af[4], bfr[2][4];
#pragma unroll
              for (int kk = 0; kk < 4; ++kk) { af[kk] = *(const LAS bf16x8*)(lds + HQE + (16 * tt + lr) * PQ + (32 * kk + 8 * g) * 2);
                  bfr[0][kk] = *(const LAS bf16x8*)(lds + HKE + (16 * st0 + lr) * PQ + (32 * kk + 8 * g) * 2); bfr[1][kk] = *(const LAS bf16x8*)(lds + HKE + (16 * (st0 + 1) + lr) * PQ + (32 * kk + 8 * g) * 2); }
              __builtin_amdgcn_sched_barrier(0);
#pragma unroll
              for (int s2 = 0; s2 < 2; ++s2) { const int st = st0 + s2; f32x4 cacc = (f32x4){0.f, 0.f, 0.f, 0.f};
                if (st <= tt) {
#pragma unroll
                    for (int kk = 0; kk < 4; ++kk) cacc = __builtin_amdgcn_mfma_f32_16x16x32_bf16(af[kk], bfr[s2][kk], cacc, 0, 0, 0);
                    if (st == tt) {
#pragma unroll
                        for (int e = 0; e < 4; ++e) if (lr > 4 * g + e) cacc[e] = 0.f;
                    }
                }
#pragma unroll
                for (int e = 0; e < 4; ++e) *(LAS unsigned short*)(lds + HSC + (16 * tt + 4 * g + e) * PT + (16 * st + lr) * 2) = (unsigned short)f2bf(cacc[e]);
              } }
            __builtin_amdgcn_sched_barrier(0);
#pragma unroll
            for (int t4 = 0; t4 < 4; ++t4) o[t4] = (f32x4){0.f, 0.f, 0.f, 0.f};
            {
                bf16x8 sf[4]; v2u qlo[4][4], qhi[4][4];
#pragma unroll
                for (int t4 = 0; t4 < 4; ++t4)
#pragma unroll
                    for (int kk = 0; kk < 4; ++kk) { qlo[t4][kk] = *(const LAS v2u*)(lds + HQE + (16 * t4 + lr) * PQ + (32 * kk + 4 * g) * 2); qhi[t4][kk] = *(const LAS v2u*)(lds + HQE + (16 * t4 + lr) * PQ + (32 * kk + 16 + 4 * g) * 2); }
#pragma unroll
                for (int kk = 0; kk < 4; ++kk) { v4u p; p.x = pk2(S[2 * kk][0], S[2 * kk][1]); p.y = pk2(S[2 * kk][2], S[2 * kk][3]); p.z = pk2(S[2 * kk + 1][0], S[2 * kk + 1][1]); p.w = pk2(S[2 * kk + 1][2], S[2 * kk + 1][3]);
                    sf[kk] = __builtin_bit_cast(bf16x8, p); }
                __builtin_amdgcn_sched_barrier(0);
#pragma unroll
                for (int kk = 0; kk < 4; ++kk)
#pragma unroll
                    for (int t4 = 0; t4 < 4; ++t4) {
                        v4u q4; q4.x = qlo[t4][kk].x; q4.y = qlo[t4][kk].y; q4.z = qhi[t4][kk].x; q4.w = qhi[t4][kk].y;
                        o[t4] = __builtin_amdgcn_mfma_f32_16x16x32_bf16(sf[kk], __builtin_bit_cast(bf16x8, q4), o[t4], 0, 0, 0);
                    }
            }
            __builtin_amdgcn_sched_barrier(0);
            bf16x8 vf[2];
            {
                bf16x8 kf[8][2]; f32x4 dec[8];
#pragma unroll
                for (int ks = 0; ks < 2; ++ks) vf[ks] = *(const LAS bf16x8*)(lds + HVT + (16 * w + lr) * PT + (32 * ks + 8 * g) * 2);
#pragma unroll
                for (int j = 0; j < 8; ++j) { dec[j] = *(const LAS f32x4*)(lds + HBEND + (16 * j + 4 * g) * 4);
#pragma unroll
                    for (int ks = 0; ks < 2; ++ks) kf[j][ks] = *(const LAS bf16x8*)(lds + HKDT + (16 * j + lr) * PT + (32 * ks + 8 * g) * 2); }
                __builtin_amdgcn_sched_barrier(0);
#pragma unroll
                for (int j = 0; j < 8; ++j) S[j] = S[j] * dec[j];
#pragma unroll
                for (int ks = 0; ks < 2; ++ks)
#pragma unroll
                    for (int j = 0; j < 8; ++j) S[j] = __builtin_amdgcn_mfma_f32_16x16x32_bf16(kf[j][ks], vf[ks], S[j], 0, 0, 0);
            }
            __builtin_amdgcn_sched_barrier(0);
            LDS_WAIT(); __builtin_amdgcn_s_barrier(); asm volatile("" ::: "memory");
            {
                bf16x8 scf[4][2];
#pragma unroll
                for (int t4 = 0; t4 < 4; ++t4)
#pragma unroll
                    for (int ks = 0; ks < 2; ++ks) if (2 * ks <= t4) scf[t4][ks] = *(const LAS bf16x8*)(lds + HSC + (16 * t4 + lr) * PT + (32 * ks + 8 * g) * 2);
                __builtin_amdgcn_sched_barrier(0);
#pragma unroll
                for (int ks = 0; ks < 2; ++ks)
#pragma unroll
                    for (int t4 = 0; t4 < 4; ++t4) if (2 * ks <= t4) o[t4] = __builtin_amdgcn_mfma_f32_16x16x32_bf16(vf[ks], scf[t4][ks], o[t4], 0, 0, 0);
            }
#pragma unroll
            for (int t4 = 0; t4 < 4; ++t4) { float ss = (o[t4][0] * o[t4][0] + o[t4][1] * o[t4][1]) + (o[t4][2] * o[t4][2] + o[t4][3] * o[t4][3]); ss += __shfl_xor(ss, 16); ss += __shfl_xor(ss, 32);
                if (g == 0) *(LAS float*)(lds + HNRM + ((16 * t4 + lr) * 8 + w) * 4) = ss; }
        }
        LDS_WAIT(); __builtin_amdgcn_s_barrier(); asm volatile("" ::: "memory");
        HG_FINALIZE(rbase + (NCHUNK - 1) * HG_CHUNK);
    }
#undef HG_FINALIZE
}

constexpr int AKB = 0, APK = 144, AVT = 36864, APV = 528;
__device__ __forceinline__ void attn_phase(LAS unsigned char* lds, const bf16* qa, const bf16* kb, const bf16* vb, bf16* ao, const float* sinks, int G, int bid, int iend, int tid, int w, int lane) {
    const int h = lane >> 5, tl = lane & 31;
    for (int item = bid; item < iend; item += G) {
        const int b = item >> 5, blk = (item >> 1) & 15, kvh = item & 1;
        __syncthreads();
        { const int r = tid >> 1, hf = tid & 1;
          const int d = tid >> 3, seg = tid & 7;
          v4u kx[4], vx[4];
          const bool lo_ok = blk > 0 || r >= 128;
          if (lo_ok) { const size_t grow = (size_t)b * SEQ + (blk - 1) * WINDOW + r; const v4u* kp = (const v4u*)(kb + grow * 128 + kvh * 64 + hf * 32);
#pragma unroll
              for (int i = 0; i < 4; ++i) kx[i] = kp[i]; }
#pragma unroll
          for (int pb = 0; pb < 2; ++pb) if (blk > 0 || pb == 1) { const v4u* vp = (const v4u*)(vb + ((((size_t)b * NBLK + (blk - 1 + pb)) * ATT_KVH + kvh) * 64 + d) * 128 + seg * 16); vx[2 * pb] = vp[0]; vx[2 * pb + 1] = vp[1]; }
          if (lo_ok) {
#pragma unroll
              for (int i = 0; i < 4; ++i) *(LAS v4u*)(lds + AKB + r * APK + (hf * 32 + 8 * i) * 2) = kx[i]; }
#pragma unroll
          for (int pb = 0; pb < 2; ++pb) if (blk > 0 || pb == 1) { *(LAS v4u*)(lds + AVT + d * APV + (pb * 128 + seg * 16) * 2) = vx[2 * pb]; *(LAS v4u*)(lds + AVT + d * APV + (pb * 128 + seg * 16 + 8) * 2) = vx[2 * pb + 1]; }
        }
        __syncthreads();
        const int head = kvh * 8 + w; const float sink = sinks[head] * 1.4426950408889634f;
        bf16x8 qn[4];
        { const size_t qrow0 = (size_t)b * SEQ + blk * WINDOW + tl;
#pragma unroll
          for (int kk = 0; kk < 4; ++kk) qn[kk] = *(const bf16x8*)(qa + qrow0 * 1024 + head * 64 + 16 * kk + 8 * h); }
#pragma unroll 1
        for (int tq = 0; tq < 4; ++tq) {
            const size_t qrow = (size_t)b * SEQ + blk * WINDOW + 32 * tq + tl;
            bf16x8 qf[4];
#pragma unroll
            for (int kk = 0; kk < 4; ++kk) qf[kk] = qn[kk];
            if (tq < 3) {
#pragma unroll
                for (int kk = 0; kk < 4; ++kk) qn[kk] = *(const bf16x8*)(qa + (qrow + 32) * 1024 + head * 64 + 16 * kk + 8 * h);
            }
            const int jlo = blk == 0 ? 4 : 0;
            f32x16 S[5];
            bf16x8 kfr[2][4];
#pragma unroll
            for (int kk = 0; kk < 4; ++kk) kfr[0][kk] = *(const LAS bf16x8*)(lds + AKB + (32 * tq + tl) * APK + (16 * kk + 8 * h) * 2);
#pragma unroll
            for (int jj = 0; jj < 5; ++jj) {
                if (jj < 4) {
#pragma unroll
                    for (int kk = 0; kk < 4; ++kk) kfr[(jj + 1) & 1][kk] = *(const LAS bf16x8*)(lds + AKB + (32 * (tq + jj + 1) + tl) * APK + (16 * kk + 8 * h) * 2);
                }
                __builtin_amdgcn_sched_barrier(0);
#pragma unroll
                for (int e = 0; e < 16; ++e) S[jj][e] = 0.f;
#pragma unroll
                for (int kk = 0; kk < 4; ++kk) S[jj] = __builtin_amdgcn_mfma_f32_32x32x16_bf16(kfr[jj & 1][kk], qf[kk], S[jj], 0, 0, 0);
                __builtin_amdgcn_sched_barrier(0);
            }
#pragma unroll
            for (int e = 0; e < 16; ++e) { const int sl = (e & 3) + 8 * (e >> 2) + 4 * h; S[0][e] = (sl > tl) ? S[0][e] : -INFINITY; S[4][e] = (sl <= tl) ? S[4][e] : -INFINITY; }
            if (blk == 0) {
#pragma unroll
                for (int jj = 0; jj < 4; ++jj) if (tq + jj < 4) {
#pragma unroll
                    for (int e = 0; e < 16; ++e) S[jj][e] = -INFINITY; }
            }
            float mx = sink;
#pragma unroll
            for (int jj = 0; jj < 5; ++jj)
#pragma unroll
                for (int e = 0; e < 16; e += 2) mx = fmaxf(mx, fmaxf(S[jj][e], S[jj][e + 1]));
            mx = fmaxf(mx, __shfl_xor(mx, 32));
            float sum = 0.f;
#pragma unroll
            for (int jj = 0; jj < 5; ++jj)
#pragma unroll
                for (int e = 0; e < 16; ++e) { S[jj][e] = __builtin_amdgcn_exp2f(S[jj][e] - mx); sum += S[jj][e]; }
            sum += __shfl_xor(sum, 32); sum += __builtin_amdgcn_exp2f(sink - mx);
            const float inv = 1.0f / sum;
            f32x16 O[2];
#pragma unroll
            for (int dt = 0; dt < 2; ++dt)
#pragma unroll
                for (int e = 0; e < 16; ++e) O[dt][e] = 0.f;
            v2u vfr[2][2][2];
#define AT_VLOAD(buf, st) do { const int j_ = tq + ((st) >> 1), a_ = (st) & 1; _Pragma("unroll") for (int dt = 0; dt < 2; ++dt) { \
                vfr[buf][dt][0] = *(const LAS v2u*)(lds + AVT + (32 * dt + tl) * APV + (32 * j_ + 16 * a_ + 4 * h) * 2); vfr[buf][dt][1] = *(const LAS v2u*)(lds + AVT + (32 * dt + tl) * APV + (32 * j_ + 16 * a_ + 8 + 4 * h) * 2); } } while (0)
            AT_VLOAD(0, 0);
#pragma unroll
            for (int st = 0; st < 10; ++st) {
                const int jj = st >> 1, a2 = st & 1;
                if (st < 9) AT_VLOAD((st + 1) & 1, st + 1);
                __builtin_amdgcn_sched_barrier(0);
                if (tq + jj >= jlo) {
                    v4u pp; pp.x = pk2(S[jj][8 * a2 + 0], S[jj][8 * a2 + 1]); pp.y = pk2(S[jj][8 * a2 + 2], S[jj][8 * a2 + 3]); pp.z = pk2(S[jj][8 * a2 + 4], S[jj][8 * a2 + 5]); pp.w = pk2(S[jj][8 * a2 + 6], S[jj][8 * a2 + 7]);
                    const bf16x8 pf = __builtin_bit_cast(bf16x8, pp);
#pragma unroll
                    for (int dt = 0; dt < 2; ++dt) { v4u v4; v4.x = vfr[st & 1][dt][0].x; v4.y = vfr[st & 1][dt][0].y; v4.z = vfr[st & 1][dt][1].x; v4.w = vfr[st & 1][dt][1].y;
                        O[dt] = __builtin_amdgcn_mfma_f32_32x32x16_bf16(__builtin_bit_cast(bf16x8, v4), pf, O[dt], 0, 0, 0); }
                }
                __builtin_amdgcn_sched_barrier(0);
            }
#undef AT_VLOAD
#pragma unroll
            for (int dt = 0; dt < 2; ++dt)
#pragma unroll
                for (int rg = 0; rg < 4; ++rg) { v2u ov; ov.x = pk2(O[dt][4 * rg] * inv, O[dt][4 * rg + 1] * inv); ov.y = pk2(O[dt][4 * rg + 2] * inv, O[dt][4 * rg + 3] * inv);
                    *(v2u*)(ao + qrow * 1024 + head * 64 + 32 * dt + 8 * rg + 4 * h) = ov; }
        }
    }
}

struct ListOrder {
    int pm0, pn0, pm1, pn1, n;
    __device__ __forceinline__ bool next(int i, pg8::Unit& u) const { if (i >= n) return false; u.pm = i == 0 ? pm0 : pm1; u.pn = i == 0 ? pn0 : pn1; return true; }
    __device__ __forceinline__ void a_ready(const pg8::Unit&) const {}
    __device__ __forceinline__ void done(const pg8::Unit&) const {}
};
constexpr int N_PHASES = 15;
__global__ void __launch_bounds__(NWAVES * 64, 2) yoco_fwd(Args args) {
    extern __shared__ __attribute__((aligned(16))) unsigned char lds_raw[];
    LAS unsigned char* lds = (LAS unsigned char*)lds_raw;
    const int tid = threadIdx.x, lane = tid & 63, wave = __builtin_amdgcn_readfirstlane(tid >> 6);
    const int G = gridDim.x, bid = blockIdx.x;
    unsigned char* ws = args.ws;
    bf16* hb = (bf16*)(ws + WS_HB); float* ssq = (float*)(ws + WS_SSQ); bf16* act = (bf16*)(ws + WS_ACT);
    const float* lbv = (const float*)(ws + WS_MISC); const float* rope = (const float*)(ws + WS_MISC + 65536);
    const int lo = args.ph_lo, hi = args.ph_hi;
    volatile LAS unsigned* bst = (volatile LAS unsigned*)(lds + 131072 + 64);
    if (tid < 4) bst[tid] = 0u;
    __syncthreads();
    XcdBarrier bar; bar.bar = (unsigned*)(ws + WS_BAR); bar.x = 0; bar.st = bst;
    if (hi - lo > 1) { bar.x = xb_xcc_id(); if (tid == 0) bst[2] = xb_add(&bar.bar[XB_XCNT(bar.x)], 1u); }
    __syncthreads();
    const int xcc = (int)bar.x, xrank = (int)bst[2];
    int xl = 0, vc = bid;
#define IN(k) (lo <= (k) && (k) < hi)
    if (lo < 0) cg::this_grid().sync();
#define SEAM(k) do { if (IN(k) && IN((k) + 1)) { if (xl && (k) != 0 && (k) != 2 && (k) != 4) xcd_local_barrier(bar.bar, bar.x, 32u); else xcd_barrier(bar); if (PROBE_DUP == 3) xcd_barrier(bar); } } while (0)
    typedef pg8::StaticOrder SO;
#define GEMM_PHASE(EPI, Aptr, Bptr, NN, KK, Eobj) do { pg8::Gemm g_{(const pg8::bf16_t*)(Aptr), (const pg8::bf16_t*)(Bptr), M, (NN), (KK)}; SO S_; S_.init(M, (NN), G, vc); \
        pg8::gemm_phase<EPI, SO, true, true>(lds, g_, S_, Eobj); } while (0)

    if (IN(0)) { if (PROBE_DUP == 1) { p0_prologue(args, lds, bid, G, wave, lane); __syncthreads(); } p0_prologue(args, lds, bid, G, wave, lane); } SEAM(0);
    if (lo == 0 && hi == N_PHASES) {
        if (tid == 0) { unsigned ok = (G == 256) ? 1u : 0u;
            for (unsigned j = 0; j < 16; ++j) { const unsigned cnt = xb_ld(&bar.bar[XB_XCNT(j)]); if (cnt != (j < 8u ? 32u : 0u)) ok = 0u; }
            bst[3] = ok; }
        __syncthreads();
        xl = (int)bst[3];
        if (xl) vc = xrank * 8 + xcc;
    }
    if (IN(1)) { pg8::EpiSwiGLU E{act, ssq}; GEMM_PHASE(pg8::EpiSwiGLU, hb, ws + WS_WGU + 0 * SZ_WGU, 2 * FF, D, E); if (PROBE_DUP == 6) { __syncthreads(); GEMM_PHASE(pg8::EpiSwiGLU, hb, ws + WS_WGU + 0 * SZ_WGU, 2 * FF, D, E); } } SEAM(1);
    if (IN(2)) { if (PROBE_DUP == 7) { pg8::EpiResid<false> E0{(bf16*)(ws + WS_R + 176 * MiB), (float*)(ws + WS_R + 240 * MiB), args.out, 0.5f}; GEMM_PHASE(pg8::EpiResid<false>, act, ws + WS_WD + 0 * SZ_WD, D, FF, E0); __syncthreads(); }
                 pg8::EpiResid<false> E{hb, ssq, args.out, 0.5f}; GEMM_PHASE(pg8::EpiResid<false>, act, ws + WS_WD + 0 * SZ_WD, D, FF, E); } SEAM(2);
    if (IN(3)) { pg8::EpiHgrnIn E{(bf16*)(ws + WS_HQ), (float*)(ws + WS_HLOGF), (long)((WS_HV - WS_HQ) / 2), (long)((WS_HG - WS_HQ) / 2), lbv, ssq}; GEMM_PHASE(pg8::EpiHgrnIn, hb, ws + WS_WIN, 4096, D, E); if (PROBE_DUP == 9) { __syncthreads(); GEMM_PHASE(pg8::EpiHgrnIn, hb, ws + WS_WIN, 4096, D, E); } } SEAM(3);
    if (IN(4)) { if (PROBE_DUP == 2) { hgrn_phase(lds, (const bf16*)(ws + WS_HQ), (const float*)(ws + WS_HLOGF), (const bf16*)(ws + WS_HV), (const bf16*)(ws + WS_HG), (bf16*)(ws + WS_KB), args.hgrn_onorm_g, G, bid, tid, wave, lane); __syncthreads(); }
                 hgrn_phase(lds, (const bf16*)(ws + WS_HQ), (const float*)(ws + WS_HLOGF), (const bf16*)(ws + WS_HV), (const bf16*)(ws + WS_HG), (bf16*)(ws + WS_HG), args.hgrn_onorm_g, xl ? BATCH * HG_HEADS : G, xl ? (xrank < 16 ? (2 * xcc + (xrank >> 3)) * 8 + (xrank & 7) : BATCH * HG_HEADS) : bid, tid, wave, lane, bar.bar, bar.x, xl ? 17 : -1);
                 __syncthreads();
                 if (xl) { if (xrank >= 16) {
                         p0_transposes<1>(args, lds, (xrank - 16) * 8 + xcc, 128, wave, lane);
                         xcd_local_barrier(bar.bar, bar.x, 32u);
                         __syncthreads();
                         const int e0 = xrank - 16, e1 = e0 + 16; const int pl0 = e0 >> 2, pl1 = e1 >> 2;
                         ListOrder LS{16 * xcc + (pl0 < 4 ? pl0 : pl0 + 4), e0 & 3, 16 * xcc + (pl1 < 4 ? pl1 : pl1 + 4), e1 & 3, 2};
                         pg8::Gemm g_{(const pg8::bf16_t*)(ws + WS_HG), (const pg8::bf16_t*)(ws + WS_WHO), M, D, D}; pg8::EpiResid<false> E5{hb, ssq, args.out, 1.0f};
                         pg8::gemm_phase<pg8::EpiResid<false>, ListOrder, true, true>(lds, g_, LS, E5); } }
                 else if (G > BATCH * HG_HEADS) { if (bid >= BATCH * HG_HEADS) p0_transposes<1>(args, lds, bid - BATCH * HG_HEADS, G - BATCH * HG_HEADS, wave, lane); } else p0_transposes<1>(args, lds, bid, G, wave, lane); } SEAM(4);
    if (IN(5)) { pg8::EpiResid<false> E{hb, ssq, args.out, 1.0f};
                 if (xl) { const int pl = xrank >> 2;
                     ListOrder LS{16 * xcc + 4 + (pl < 4 ? pl : pl + 4), xrank & 3, 0, 0, 1};
                     pg8::Gemm g_{(const pg8::bf16_t*)(ws + WS_HG), (const pg8::bf16_t*)(ws + WS_WHO), M, D, D};
                     pg8::gemm_phase<pg8::EpiResid<false>, ListOrder, true, true>(lds, g_, LS, E); }
                 else GEMM_PHASE(pg8::EpiResid<false>, ws + WS_HG, ws + WS_WHO, D, D, E); } SEAM(5);
    if (IN(6)) { pg8::EpiSwiGLU E{act, ssq}; GEMM_PHASE(pg8::EpiSwiGLU, hb, ws + WS_WGU + 1 * SZ_WGU, 2 * FF, D, E); } SEAM(6);
    if (IN(7)) { pg8::EpiResid<false> E{hb, ssq, args.out, 0.5f}; GEMM_PHASE(pg8::EpiResid<false>, act, ws + WS_WD + 1 * SZ_WD, D, FF, E); } SEAM(7);
    if (IN(8)) { pg8::EpiHead<false> E{(bf16*)(ws + WS_KB), (long)((WS_VB - WS_KB) / 2), args.k_norm_g, rope, ssq, 1.0f}; GEMM_PHASE(pg8::EpiHead<false>, hb, ws + WS_WKV, 256, D, E); if (PROBE_DUP == 8) { __syncthreads(); GEMM_PHASE(pg8::EpiHead<false>, hb, ws + WS_WKV, 256, D, E); }
                 __syncthreads();
                 pg8::EpiSwiGLU E2{act, ssq}; GEMM_PHASE(pg8::EpiSwiGLU, hb, ws + WS_WGU + 2 * SZ_WGU, 2 * FF, D, E2); } SEAM(8);
    if (IN(9)) { pg8::EpiResid<false> E{hb, ssq, args.out, 0.5f}; GEMM_PHASE(pg8::EpiResid<false>, act, ws + WS_WD + 2 * SZ_WD, D, FF, E); } SEAM(9);
    if (IN(10)) { pg8::EpiHead<true> E{(bf16*)(ws + WS_QA), 0l, args.q_norm_g, rope, ssq, 0.125f * 1.4426950408889634f}; GEMM_PHASE(pg8::EpiHead<true>, hb, ws + WS_WQ, D, D, E); } SEAM(10);
    if (IN(11)) { if (PROBE_DUP == 4) { attn_phase(lds, (const bf16*)(ws + WS_QA), (const bf16*)(ws + WS_KB), (const bf16*)(ws + WS_VB), (bf16*)(ws + WS_R + 128 * MiB), args.attn_sinks, G, bid, BATCH * NBLK * ATT_KVH, tid, wave, lane); __syncthreads(); }
                  attn_phase(lds, (const bf16*)(ws + WS_QA), (const bf16*)(ws + WS_KB), (const bf16*)(ws + WS_VB), (bf16*)(ws + WS_QA), args.attn_sinks, xl ? 32 : G, xl ? 64 * xcc + xrank : bid, xl ? 64 * xcc + 64 : BATCH * NBLK * ATT_KVH, tid, wave, lane); } SEAM(11);
    if (IN(12)) { if (PROBE_DUP == 10) { pg8::EpiResid<false> E0{(bf16*)(ws + WS_R + 176 * MiB), (float*)(ws + WS_R + 240 * MiB), args.out, 1.0f}; GEMM_PHASE(pg8::EpiResid<false>, ws + WS_QA, ws + WS_WAO, D, D, E0); __syncthreads(); }
                  pg8::EpiResid<false> E{hb, ssq, args.out, 1.0f}; GEMM_PHASE(pg8::EpiResid<false>, ws + WS_QA, ws + WS_WAO, D, D, E); } SEAM(12);
    if (IN(13)) { pg8::EpiSwiGLU E{act, ssq}; GEMM_PHASE(pg8::EpiSwiGLU, hb, ws + WS_WGU + 3 * SZ_WGU, 2 * FF, D, E); } SEAM(13);
    if (IN(14)) { pg8::EpiResid<true> E{hb, ssq, args.out, 0.5f}; GEMM_PHASE(pg8::EpiResid<true>, act, ws + WS_WD + 3 * SZ_WD, D, FF, E); }
#undef IN
#undef SEAM
#undef GEMM_PHASE
}

extern "C" void kernel_launch(void* const* d_in, const int* in_sizes, int n_in, void* d_out, int out_size, void* d_ws, size_t ws_size, hipStream_t stream) {
    static int grid = 0;
    if (grid == 0) {
        if (n_in != 16 || in_sizes[0] != M * D || out_size != M * D || ws_size < WS_END) { fprintf(stderr, "kernel_launch: unexpected problem (n_in %d, in0 %d, out %d, ws %zu, need %zu)\n", n_in, n_in > 0 ? in_sizes[0] : -1, out_size, ws_size, (size_t)WS_END); grid = -1; return; }
        int dev = 0, cus = 0, per_cu = 0;
        if (hipGetDevice(&dev) != hipSuccess || hipDeviceGetAttribute(&cus, hipDeviceAttributeMultiprocessorCount, dev) != hipSuccess) { grid = -1; return; }
        if (hipFuncSetAttribute((const void*)yoco_fwd, hipFuncAttributeMaxDynamicSharedMemorySize, LDS_BYTES) != hipSuccess) { fprintf(stderr, "kernel_launch: hipFuncSetAttribute failed\n"); grid = -1; return; }
        if (hipOccupancyMaxActiveBlocksPerMultiprocessor(&per_cu, (const void*)yoco_fwd, NWAVES * 64, LDS_BYTES) != hipSuccess || per_cu < 1) { fprintf(stderr, "kernel_launch: occupancy query says %d\n", per_cu); per_cu = 1; }
        (void)hipGetLastError();
        grid = cus;
    }
    if (grid < 0) return;
    Args a{};
    a.x = (const float*)d_in[0]; a.ffn_norm_g = (const float*)d_in[1]; a.ffn_w_gate_up = (const float*)d_in[2]; a.ffn_w_down = (const float*)d_in[3]; a.mix_norm_g = (const float*)d_in[4];
    a.hgrn_w_in = (const float*)d_in[5]; a.hgrn_lb_logits = (const float*)d_in[6]; a.hgrn_onorm_g = (const float*)d_in[7]; a.hgrn_w_out = (const float*)d_in[8]; a.kv_norm_g = (const float*)d_in[9];
    a.kv_w = (const float*)d_in[10]; a.k_norm_g = (const float*)d_in[11]; a.attn_w_q = (const float*)d_in[12]; a.q_norm_g = (const float*)d_in[13]; a.attn_sinks = (const float*)d_in[14]; a.attn_w_out = (const float*)d_in[15];
    a.out = (float*)d_out; a.ws = (unsigned char*)d_ws;
#if MK_ONE_LAUNCH
    if (hipMemsetAsync((char*)d_ws + WS_BAR, 0, BAR_BYTES, stream) != hipSuccess) { fprintf(stderr, "kernel_launch: memset failed\n"); return; }
    a.ph_lo = 0; a.ph_hi = N_PHASES;
    void* kargs[] = {&a};
    hipError_t e = hipLaunchCooperativeKernel((const void*)yoco_fwd, dim3(grid), dim3(NWAVES * 64), kargs, LDS_BYTES, stream);
    if (e != hipSuccess) fprintf(stderr, "kernel_launch: cooperative launch failed: %s (grid %d)\n", hipGetErrorString(e), grid);
#else
    for (int p = 0; p < N_PHASES; ++p) { a.ph_lo = p; a.ph_hi = p + 1; hipLaunchKernelGGL(yoco_fwd, dim3(grid), dim3(NWAVES * 64), LDS_BYTES, stream, a); }
#endif
}
```

```cpp
#include <hip/hip_runtime.h>
#include <hip/hip_cooperative_groups.h>
#include <cstdio>
#include <cstdint>
namespace cg = cooperative_groups;
namespace pg8 {
#define PG8_LAS __attribute__((address_space(3)))
typedef unsigned short bf16_t;
typedef short bf16x8 __attribute__((ext_vector_type(8)));
typedef float f32x4 __attribute__((ext_vector_type(4)));
typedef unsigned u32x4 __attribute__((ext_vector_type(4)));
constexpr int BM = 256, BK = 64, HALF = 128, HTB = HALF * BK * 2  , STAGE_BYTES = 8 * HTB, NXCD = 8, WGM = 4;

__host__ __device__ __forceinline__ int lds_byte(int r, int c) { const int st = (r >> 4) * 2 + (c >> 5), rr = r & 15, cc = c & 31, ob = rr * 64 + cc * 2; return st * 1024 + (ob ^ (((ob >> 9) & 1) << 5)); }
__host__ __device__ __forceinline__ void stage_rc(int b, int& R, int& C) { const int st = b / 1024, sb = b % 1024, swz = sb ^ (((sb >> 9) & 1) << 5); R = (st >> 1) * 16 + swz / 64; C = (st & 1) * 32 + (swz % 64) / 2; }
__host__ __device__ __forceinline__ int perm32(int rho) { const int n = rho >> 4, i = rho & 15; return 8 * (i >> 2) + 4 * n + (i & 3); }

struct Unit { int pm, pn; };
struct Gemm { const bf16_t* A; const bf16_t* Bt; int M, N, K; };

struct StaticOrder {
    int nM, nN, nwg, G, c;
    __host__ __device__ void init(int M, int N, int G_, int c_) { nM = M / BM; nN = N / BM; nwg = nM * nN; G = G_; c = c_; }
    __host__ __device__ bool next(int i, Unit& u) const {
        const long L = (long)i * G + c; if (L >= nwg) return false;
        int wgid = (int)L; { const int q = nwg / NXCD, r = nwg % NXCD, xcd = wgid % NXCD, off = wgid / NXCD; wgid = (xcd < r ? xcd * (q + 1) : r * (q + 1) + (xcd - r) * q) + off; }
        const int nig = WGM * nN, gid = wgid / nig, fm = gid * WGM, gsz = (nM - fm) < WGM ? (nM - fm) : WGM;
        u.pm = fm + ((wgid % nig) % gsz); u.pn = (wgid % nig) / gsz; return true;
    }
    __device__ __forceinline__ void a_ready(const Unit&) const {}
    __device__ __forceinline__ void done(const Unit&) const {}
};

__device__ __forceinline__ unsigned cvt_pk_bf16(float lo, float hi) { unsigned r; asm volatile("v_cvt_pk_bf16_f32 %0, %1, %2" : "=v"(r) : "v"(lo), "v"(hi)); return r; }
typedef float f32x2 __attribute__((ext_vector_type(2)));
#ifndef MK_WT_STORES
#define MK_WT_STORES 0
#endif
__device__ __forceinline__ void st16(void* p, u32x4 v) {
#if MK_WT_STORES
    asm volatile("global_store_dwordx4 %0, %1, off sc1\n\ts_nop 1" :: "v"(p), "v"(v) : "memory");
#else
    *(u32x4*)p = v;
#endif
}
__device__ __forceinline__ float fast_rcp(float x) { return __builtin_amdgcn_rcpf(x); }
__device__ __forceinline__ float silu_f(float x) { return x * fast_rcp(1.0f + __expf(-x)); }
__device__ __forceinline__ float sigmoid_f(float x) { return fast_rcp(1.0f + __expf(-x)); }
__device__ __forceinline__ float row_rstd(const float* ssq, int row) {
    const f32x4* p = (const f32x4*)(ssq + (size_t)row * 16);
    const f32x4 a = p[0], b = p[1], c = p[2], d = p[3];
    const float s = (((a[0] + a[1]) + (a[2] + a[3])) + ((b[0] + b[1]) + (b[2] + b[3]))) + (((c[0] + c[1]) + (c[2] + c[3])) + ((d[0] + d[1]) + (d[2] + d[3])));
    return 1.0f / sqrtf(s * (1.0f / 1024.0f) + 1e-6f);
}
__device__ __forceinline__ void row_rstd8(const float* ssq, int row0, int fq, float (&rs)[8]) {
    f32x4 pv[8];
#pragma unroll
    for (int r = 0; r < 8; ++r) pv[r] = *(const f32x4*)(ssq + (size_t)(row0 + (r >> 2) * HALF + (r & 3) * 16) * 16 + 4 * fq);
#pragma unroll
    for (int r = 0; r < 8; ++r) { float t = (pv[r][0] + pv[r][1]) + (pv[r][2] + pv[r][3]); t += __shfl_xor(t, 16); t += __shfl_xor(t, 32); rs[r] = 1.0f / sqrtf(t * (1.0f / 1024.0f) + 1e-6f); }
}
struct EpiSwiGLU {
    static constexpr bool PERM = true, AFTER_DRAIN = false;
    bf16_t* O; const float* ssq;
    __device__ __forceinline__ void operator()(const f32x4 (&acc)[2][2][4][2], const Unit& u, int wr, int wc, int fr, int fq) const {
        typedef float f2 __attribute__((ext_vector_type(2)));
        const int row0 = u.pm * BM + wr * 64 + fr, col0 = u.pn * 128 + wc * 32 + 8 * fq;
        float rsv[8]; row_rstd8(ssq, row0, fq, rsv);
#pragma unroll
        for (int ai = 0; ai < 2; ++ai)
#pragma unroll
            for (int m = 0; m < 4; ++m) {
                const int row = row0 + ai * HALF + m * 16; const float rs = rsv[ai * 4 + m];
                const float nrl = rs * -1.4426950408889634f, rs2 = rs * rs;
                unsigned w4[4];
#pragma unroll
                for (int n = 0; n < 2; ++n)
#pragma unroll
                    for (int e = 0; e < 4; e += 2) {
                        const f2 g = (f2){acc[ai][0][m][n][e], acc[ai][0][m][n][e + 1]}, up = (f2){acc[ai][1][m][n][e], acc[ai][1][m][n][e + 1]};
                        const f2 t = g * nrl; f2 ex; ex.x = __builtin_amdgcn_exp2f(t.x); ex.y = __builtin_amdgcn_exp2f(t.y);
                        const f2 d = ex + 1.0f; f2 r; r.x = __builtin_amdgcn_rcpf(d.x); r.y = __builtin_amdgcn_rcpf(d.y);
                        const f2 o = ((g * up) * rs2) * r;
                        w4[2 * n + (e >> 1)] = cvt_pk_bf16(o.x, o.y);
                    }
                u32x4 w; w.x = w4[0]; w.y = w4[1]; w.z = w4[2]; w.w = w4[3];
                st16(O + (size_t)row * 2816 + col0, w);
            }
    }
};
template <bool FINAL> struct EpiResid {
    static constexpr bool PERM = true, AFTER_DRAIN = false;
    bf16_t* hb; float* ssq; float* out; float scale;
    __device__ __forceinline__ void operator()(const f32x4 (&acc)[2][2][4][2], const Unit& u, int wr, int wc, int fr, int fq) const {
        const int row0 = u.pm * BM + wr * 64 + fr, col0 = u.pn * BM + wc * 32 + 8 * fq;
        u32x4 bs[2][4][2];
#pragma unroll
        for (int ai = 0; ai < 2; ++ai)
#pragma unroll
            for (int m = 0; m < 4; ++m)
#pragma unroll
                for (int bj = 0; bj < 2; ++bj) bs[ai][m][bj] = *(const u32x4*)(hb + (size_t)(row0 + ai * HALF + m * 16) * 1024 + col0 + bj * HALF);
#pragma unroll
        for (int ai = 0; ai < 2; ++ai) {
#pragma unroll
            for (int m = 0; m < 4; ++m) {
                const int row = row0 + ai * HALF + m * 16; const size_t off = (size_t)row * 1024 + col0; float ss = 0.f;
#pragma unroll
                for (int bj = 0; bj < 2; ++bj) {
                    const u32x4 b = bs[ai][m][bj];
                    f32x4 o0, o1;
                    o0[0] = __builtin_bit_cast(float, b.x << 16) + acc[ai][bj][m][0][0] * scale; o0[1] = __builtin_bit_cast(float, b.x & 0xffff0000u) + acc[ai][bj][m][0][1] * scale;
                    o0[2] = __builtin_bit_cast(float, b.y << 16) + acc[ai][bj][m][0][2] * scale; o0[3] = __builtin_bit_cast(float, b.y & 0xffff0000u) + acc[ai][bj][m][0][3] * scale;
                    o1[0] = __builtin_bit_cast(float, b.z << 16) + acc[ai][bj][m][1][0] * scale; o1[1] = __builtin_bit_cast(float, b.z & 0xffff0000u) + acc[ai][bj][m][1][1] * scale;
                    o1[2] = __builtin_bit_cast(float, b.w << 16) + acc[ai][bj][m][1][2] * scale; o1[3] = __builtin_bit_cast(float, b.w & 0xffff0000u) + acc[ai][bj][m][1][3] * scale;
                    if (FINAL) { *(f32x4*)(out + off + bj * HALF) = o0; *(f32x4*)(out + off + bj * HALF + 4) = o1; }
                    else { u32x4 w; w.x = cvt_pk_bf16(o0[0], o0[1]); w.y = cvt_pk_bf16(o0[2], o0[3]); w.z = cvt_pk_bf16(o1[0], o1[1]); w.w = cvt_pk_bf16(o1[2], o1[3]); st16(hb + off + bj * HALF, w);
                        ss += ((o0[0] * o0[0] + o0[1] * o0[1]) + (o0[2] * o0[2] + o0[3] * o0[3])) + ((o1[0] * o1[0] + o1[1] * o1[1]) + (o1[2] * o1[2] + o1[3] * o1[3])); }
                }
                if (!FINAL) { ss += __shfl_xor(ss, 16); ss += __shfl_xor(ss, 32); if (fq == 0) ssq[(size_t)row * 16 + u.pn * 4 + wc] = ss; }
            }
        }
    }
};
struct EpiHgrnIn {
    static constexpr bool PERM = true, AFTER_DRAIN = false;
    bf16_t* qb; float* logf; long off_v; long off_g; const float* lbv; const float* ssq;
    template <int REGION> __device__ __forceinline__ void body(const f32x4 (&acc)[2][2][4][2], const Unit& u, int wr, int wc, int fr, int fq) const {
        typedef float f2 __attribute__((ext_vector_type(2)));
        const int row0 = u.pm * BM + wr * 64 + fr, col0 = (u.pn & 3) * BM + wc * 32 + 8 * fq;
        float rsv[8]; row_rstd8(ssq, row0, fq, rsv);
        f32x4 lb[2][2];
        if (REGION == 1) {
#pragma unroll
            for (int bj = 0; bj < 2; ++bj)
#pragma unroll
                for (int n = 0; n < 2; ++n) lb[bj][n] = *(const f32x4*)(lbv + col0 + bj * HALF + 4 * n);
        }
        bf16_t* dst = REGION == 0 ? qb : (REGION == 1 ? (bf16_t*)logf : (REGION == 2 ? qb + off_v : qb + off_g));
#pragma unroll
        for (int ai = 0; ai < 2; ++ai)
#pragma unroll
            for (int m = 0; m < 4; ++m) {
                const int row = row0 + ai * HALF + m * 16; const float rs = rsv[ai * 4 + m]; const size_t off = (size_t)row * 1024 + col0;
                const float nrl = rs * -1.4426950408889634f;
#pragma unroll
                for (int bj = 0; bj < 2; ++bj) {
                    f32x4 vv[2];
#pragma unroll
                    for (int n = 0; n < 2; ++n)
#pragma unroll
                        for (int e = 0; e < 4; e += 2) {
                            const f2 a = (f2){acc[ai][bj][m][n][e], acc[ai][bj][m][n][e + 1]};
                            f2 o;
                            if (REGION == 2) o = a * rs;
                            else {
                                const f2 t = a * nrl; f2 ex; ex.x = __builtin_amdgcn_exp2f(t.x); ex.y = __builtin_amdgcn_exp2f(t.y);
                                const f2 d = ex + 1.0f; f2 sg; sg.x = __builtin_amdgcn_rcpf(d.x); sg.y = __builtin_amdgcn_rcpf(d.y);
                                if (REGION == 1) { const f2 l = (f2){lb[bj][n][e], lb[bj][n][e + 1]}; o = l + (1.0f - l) * sg; }
                                else o = (a * rs) * sg;
                            }
                            vv[n][e] = o.x; vv[n][e + 1] = o.y;
                        }
                    u32x4 w;
                    if (REGION == 1) {
                        typedef _Float16 h2v __attribute__((ext_vector_type(2)));
                        w.x = __builtin_bit_cast(unsigned, __builtin_convertvector((f2){vv[0][0], vv[0][1]}, h2v)); w.y = __builtin_bit_cast(unsigned, __builtin_convertvector((f2){vv[0][2], vv[0][3]}, h2v));
                        w.z = __builtin_bit_cast(unsigned, __builtin_convertvector((f2){vv[1][0], vv[1][1]}, h2v)); w.w = __builtin_bit_cast(unsigned, __builtin_convertvector((f2){vv[1][2], vv[1][3]}, h2v));
                    } else { w.x = cvt_pk_bf16(vv[0][0], vv[0][1]); w.y = cvt_pk_bf16(vv[0][2], vv[0][3]); w.z = cvt_pk_bf16(vv[1][0], vv[1][1]); w.w = cvt_pk_bf16(vv[1][2], vv[1][3]); }
                    st16(dst + off + bj * HALF, w);
                }
            }
    }
    __device__ __forceinline__ void operator()(const f32x4 (&acc)[2][2][4][2], const Unit& u, int wr, int wc, int fr, int fq) const {
        const int region = u.pn >> 2;
        if (region == 0) body<0>(acc, u, wr, wc, fr, fq); else if (region == 1) body<1>(acc, u, wr, wc, fr, fq); else if (region == 2) body<2>(acc, u, wr, wc, fr, fq); else body<3>(acc, u, wr, wc, fr, fq);
    }
};
template <bool IS_Q> struct EpiHead {
    static constexpr bool PERM = true, AFTER_DRAIN = false;
    bf16_t* O; long off2; const float* gain; const float* rope; const float* ssq; float oscale;
    __device__ __forceinline__ void operator()(const f32x4 (&acc)[2][2][4][2], const Unit& u, int wr, int wc, int fr, int fq) const {
        const int row0 = u.pm * BM + wr * 64 + fr;
        const bool normed = IS_Q || wc < 2;
        float rsv[8]; row_rstd8(ssq, row0, fq, rsv);
        f32x4 gn[2][2];
#pragma unroll
        for (int bj = 0; bj < 2; ++bj)
#pragma unroll
            for (int n = 0; n < 2; ++n) gn[bj][n] = *(const f32x4*)(gain + bj * 32 + 8 * fq + 4 * n);
        bf16_t* dst; int ldo, cbase;
        if (IS_Q) { dst = O; ldo = 1024; cbase = (u.pn * 4 + wc) * 64; } else { dst = O + (wc < 2 ? 0l : off2); ldo = 128; cbase = (wc & 1) * 64; }
#pragma unroll
        for (int ai = 0; ai < 2; ++ai)
#pragma unroll
            for (int m = 0; m < 4; ++m) {
                const int row = row0 + ai * HALF + m * 16; const float rs = rsv[ai * 4 + m];
                f32x4 v[2][2]; float ss = 0.f;
#pragma unroll
                for (int bj = 0; bj < 2; ++bj)
#pragma unroll
                    for (int n = 0; n < 2; ++n) { v[bj][n] = acc[ai][bj][m][n] * rs; ss += (v[bj][n][0] * v[bj][n][0] + v[bj][n][1] * v[bj][n][1]) + (v[bj][n][2] * v[bj][n][2] + v[bj][n][3] * v[bj][n][3]); }
                ss += __shfl_xor(ss, 16); ss += __shfl_xor(ss, 32);
                if (normed) {
                    const float r = 1.0f / sqrtf(ss * (1.0f / 64.0f) + 1e-6f);
#pragma unroll
                    for (int bj = 0; bj < 2; ++bj)
#pragma unroll
                        for (int n = 0; n < 2; ++n) v[bj][n] = v[bj][n] * r * gn[bj][n];
                }
                f32x4 p0, p1;
#pragma unroll
                for (int e = 0; e < 4; ++e) { p0[e] = __shfl_xor(v[0][0][e], 16); p1[e] = __shfl_xor(v[0][1][e], 16); }
                if (normed && fq < 2) {
                    const f32x4* cs = (const f32x4*)(rope + (size_t)(row & 2047) * 16);
                    const f32x4 c0 = cs[0], c1 = cs[1], c2 = cs[2], c3 = cs[3];
                    const float sg = fq == 0 ? -1.0f : 1.0f;
                    v[0][0][0] = v[0][0][0] * c0[0] + sg * p0[0] * c0[1]; v[0][0][1] = v[0][0][1] * c0[2] + sg * p0[1] * c0[3];
                    v[0][0][2] = v[0][0][2] * c1[0] + sg * p0[2] * c1[1]; v[0][0][3] = v[0][0][3] * c1[2] + sg * p0[3] * c1[3];
                    v[0][1][0] = v[0][1][0] * c2[0] + sg * p1[0] * c2[1]; v[0][1][1] = v[0][1][1] * c2[2] + sg * p1[1] * c2[3];
                    v[0][1][2] = v[0][1][2] * c3[0] + sg * p1[2] * c3[1]; v[0][1][3] = v[0][1][3] * c3[2] + sg * p1[3] * c3[3];
                }
                if (!IS_Q && wc >= 2) {
                    const int bb = row >> 11, blk = (row >> 7) & 15, sl = row & 127;
                    bf16_t* vt = O + off2 + ((((size_t)bb * 16 + blk) * 2 + (wc & 1)) * 64) * 128 + sl;
#pragma unroll
                    for (int bj = 0; bj < 2; ++bj)
#pragma unroll
                        for (int n = 0; n < 2; ++n)
#pragma unroll
                            for (int e = 0; e < 4; e += 2) { const unsigned pk = cvt_pk_bf16(v[bj][n][e], v[bj][n][e + 1]); const int d = bj * 32 + 8 * fq + 4 * n + e;
                                vt[(size_t)d * 128] = (bf16_t)(pk & 0xffffu); vt[(size_t)(d + 1) * 128] = (bf16_t)(pk >> 16); }
                } else {
#pragma unroll
                for (int bj = 0; bj < 2; ++bj) {
                    const f32x4 a = v[bj][0] * oscale, b = v[bj][1] * oscale;
                    u32x4 w; w.x = cvt_pk_bf16(a[0], a[1]); w.y = cvt_pk_bf16(a[2], a[3]); w.z = cvt_pk_bf16(b[0], b[1]); w.w = cvt_pk_bf16(b[2], b[3]);
                    st16(dst + (size_t)row * ldo + cbase + bj * 32 + 8 * fq, w);
                }
                }
            }
    }
};

template <class Epi, class Sched, bool ALIGN_EPI = false, bool SP2 = false>
__device__ __forceinline__ void gemm_phase(PG8_LAS unsigned char* lds, const Gemm g, const Sched& S, const Epi& E) {
    const int tid = threadIdx.x, wid = __builtin_amdgcn_readfirstlane(tid >> 6), lane = tid & 63, wr = wid >> 2, wc = wid & 3, fr = lane & 15, fq = lane >> 4;
    const int K = g.K, nt = K / BK;
    unsigned voffA[2], voffB[2];
#pragma unroll
    for (int i = 0; i < 2; ++i) { int R, C; stage_rc(tid * 16 + i * 8192, R, C); const int Rb = Epi::PERM ? ((R & ~31) + perm32(R & 31)) : R;
        voffA[i] = (unsigned)(R * K + C) * 2u; voffB[i] = (unsigned)(Rb * K + C) * 2u; }
    const size_t kstep = (size_t)(BK * 2);
    const size_t hstep = (size_t)HALF * K * 2;
    const size_t tstep = 2 * hstep;
    const unsigned ldsw = (unsigned)wid * 1024u;
    const int aoff = lds_byte(wr * 64 + fr, fq * 8), boff = lds_byte(wc * 32 + fr, fq * 8);
#define PG8_SA(b, h) (((b) * 2 + (h)) * HTB)
#define PG8_SB(b, h) ((4 + (b) * 2 + (h)) * HTB)
#define PG8_STAGE(bufoff, gbase, voff) do { _Pragma("unroll") for (int _i = 0; _i < 2; ++_i) \
        __builtin_amdgcn_global_load_lds((const unsigned*)((const char*)(gbase) + (voff)[_i]), (PG8_LAS unsigned*)(lds + (bufoff) + ldsw + _i * 8192), 16, 0, 0); } while (0)
#define PG8_LDA(dst, b, h) do { _Pragma("unroll") for (int m = 0; m < 4; ++m) _Pragma("unroll") for (int k = 0; k < 2; ++k) dst[m][k] = *(const PG8_LAS bf16x8*)(lds + PG8_SA(b, h) + aoff + m * 2048 + k * 1024); } while (0)
#define PG8_LDB(dst, b, h) do { _Pragma("unroll") for (int n = 0; n < 2; ++n) _Pragma("unroll") for (int k = 0; k < 2; ++k) dst[n][k] = *(const PG8_LAS bf16x8*)(lds + PG8_SB(b, h) + boff + n * 2048 + k * 1024); } while (0)
#define PG8_MMA(ai, bj, At, Bt) do { __builtin_amdgcn_s_setprio(1); _Pragma("unroll") for (int m = 0; m < 4; ++m) _Pragma("unroll") for (int n = 0; n < 2; ++n) _Pragma("unroll") for (int k = 0; k < 2; ++k) \
        acc[ai][bj][m][n] = __builtin_amdgcn_mfma_f32_16x16x32_bf16(Bt[n][k], At[m][k], acc[ai][bj][m][n], 0, 0, 0); __builtin_amdgcn_s_setprio(0); } while (0)
#define PG8_WAIT_V(n) asm volatile("s_waitcnt vmcnt(" #n ")" ::: "memory")
#define PG8_WAIT_L(n) asm volatile("s_waitcnt lgkmcnt(" #n ")" ::: "memory")
#define PG8_BAR __builtin_amdgcn_s_barrier()
#define PG8_SCHED __builtin_amdgcn_sched_barrier(0)
    Unit cur, nxt; int ui = 0;
    if (!S.next(0, cur)) return;
    f32x4 acc[2][2][4][2];
#pragma unroll
    for (int a = 0; a < 2; ++a)
#pragma unroll
        for (int b = 0; b < 2; ++b)
#pragma unroll
            for (int m = 0; m < 4; ++m)
#pragma unroll
                for (int n = 0; n < 2; ++n) acc[a][b][m][n] = (f32x4){0.f, 0.f, 0.f, 0.f};
    bf16x8 At[4][2], B0[2][2], B1[2][2];
    const char* cA = (const char*)g.A + (size_t)cur.pm * tstep; const char* cB = (const char*)g.Bt + (size_t)cur.pn * tstep;
    S.a_ready(cur);
    if constexpr (SP2) {
        PG8_STAGE(PG8_SB(0, 0), cB, voffB); PG8_STAGE(PG8_SB(0, 1), cB + hstep, voffB); PG8_STAGE(PG8_SA(0, 0), cA, voffA); PG8_STAGE(PG8_SA(0, 1), cA + hstep, voffA);
        if (wr == 1) PG8_BAR;
        PG8_WAIT_V(2); PG8_BAR;
        PG8_STAGE(PG8_SB(1, 0), cB + kstep, voffB); PG8_STAGE(PG8_SA(1, 0), cA + kstep, voffA); PG8_STAGE(PG8_SB(1, 1), cB + hstep + kstep, voffB);
        PG8_WAIT_V(6); PG8_BAR;
    } else {
        PG8_STAGE(PG8_SB(0, 0), cB, voffB); PG8_STAGE(PG8_SA(0, 0), cA, voffA); PG8_STAGE(PG8_SB(0, 1), cB + hstep, voffB); PG8_STAGE(PG8_SA(0, 1), cA + hstep, voffA);
        if (wr == 1) PG8_BAR;
        PG8_WAIT_V(4); PG8_BAR;
        PG8_STAGE(PG8_SB(1, 0), cB + kstep, voffB); PG8_STAGE(PG8_SA(1, 0), cA + kstep, voffA); PG8_STAGE(PG8_SB(1, 1), cB + hstep + kstep, voffB);
        PG8_WAIT_V(6); PG8_BAR;
    }
    for (;;) {
        const bool has_next = S.next(ui + 1, nxt);
        const char* nA = has_next ? (const char*)g.A + (size_t)nxt.pm * tstep : cA; const char* nB = has_next ? (const char*)g.Bt + (size_t)nxt.pn * tstep : cB;
        for (int t = 0; t < nt; t += 2) {
            const bool last = (t == nt - 2);
            const char* a1 = cA + (size_t)(t + 1) * kstep;
            const char* a2 = last ? nA : cA + (size_t)(t + 2) * kstep; const char* b2 = last ? nB : cB + (size_t)(t + 2) * kstep;
            const char* a3 = a2 + kstep; const char* b3 = b2 + kstep;
            if (last && has_next) S.a_ready(nxt);
            if constexpr (SP2) {
            PG8_LDB(B0, 0, 0); PG8_LDB(B1, 0, 1); PG8_SCHED; PG8_LDA(At, 0, 0); PG8_STAGE(PG8_SA(1, 1), a1 + hstep, voffA);
            PG8_WAIT_V(8); PG8_WAIT_L(0); PG8_BAR; PG8_MMA(0, 0, At, B0); PG8_MMA(0, 1, At, B1); PG8_BAR; PG8_SCHED;
            PG8_LDA(At, 0, 1); PG8_STAGE(PG8_SB(0, 0), b2, voffB); PG8_STAGE(PG8_SB(0, 1), b2 + hstep, voffB); PG8_STAGE(PG8_SA(0, 0), a2, voffA);
            PG8_WAIT_V(8); PG8_WAIT_L(0); PG8_BAR; PG8_MMA(1, 0, At, B0); PG8_MMA(1, 1, At, B1); PG8_BAR; PG8_SCHED;
            PG8_LDB(B0, 1, 0); PG8_LDB(B1, 1, 1); PG8_SCHED; PG8_LDA(At, 1, 0); PG8_STAGE(PG8_SA(0, 1), a2 + hstep, voffA);
            PG8_WAIT_V(8); PG8_WAIT_L(0); PG8_BAR; PG8_MMA(0, 0, At, B0); PG8_MMA(0, 1, At, B1); PG8_BAR; PG8_SCHED;
            PG8_LDA(At, 1, 1); PG8_STAGE(PG8_SB(1, 0), b3, voffB); PG8_STAGE(PG8_SB(1, 1), b3 + hstep, voffB); PG8_STAGE(PG8_SA(1, 0), a3, voffA);
            PG8_WAIT_V(8); PG8_WAIT_L(0); PG8_BAR; PG8_MMA(1, 0, At, B0); PG8_MMA(1, 1, At, B1); PG8_BAR; PG8_SCHED;
            } else {
            PG8_LDB(B0, 0, 0); PG8_SCHED; PG8_LDA(At, 0, 0); PG8_STAGE(PG8_SA(1, 1), a1 + hstep, voffA);
            PG8_WAIT_L(8); PG8_BAR; PG8_WAIT_L(0); PG8_MMA(0, 0, At, B0); PG8_BAR; PG8_SCHED;
            PG8_LDB(B1, 0, 1); PG8_STAGE(PG8_SB(0, 0), b2, voffB);
            PG8_BAR; PG8_WAIT_L(0); PG8_MMA(0, 1, At, B1); PG8_BAR;
            PG8_LDA(At, 0, 1); PG8_STAGE(PG8_SA(0, 0), a2, voffA);
            PG8_BAR; PG8_WAIT_L(0); PG8_MMA(1, 0, At, B0); PG8_BAR; PG8_SCHED;
            PG8_STAGE(PG8_SB(0, 1), b2 + hstep, voffB);
            PG8_WAIT_V(6); PG8_BAR; PG8_MMA(1, 1, At, B1); PG8_BAR;
            PG8_LDB(B0, 1, 0); PG8_SCHED; PG8_LDA(At, 1, 0); PG8_STAGE(PG8_SA(0, 1), a2 + hstep, voffA);
            PG8_WAIT_L(8); PG8_BAR; PG8_WAIT_L(0); PG8_MMA(0, 0, At, B0); PG8_BAR; PG8_SCHED;
            PG8_LDB(B1, 1, 1); PG8_STAGE(PG8_SB(1, 0), b3, voffB);
            PG8_BAR; PG8_WAIT_L(0); PG8_MMA(0, 1, At, B1); PG8_BAR;
            PG8_LDA(At, 1, 1); PG8_STAGE(PG8_SA(1, 0), a3, voffA);
            PG8_BAR; PG8_WAIT_L(0); PG8_MMA(1, 0, At, B0); PG8_BAR; PG8_SCHED;
            PG8_STAGE(PG8_SB(1, 1), b3 + hstep, voffB);
            PG8_WAIT_V(6); PG8_BAR; PG8_MMA(1, 1, At, B1); PG8_BAR;
            }
        }
        if constexpr (ALIGN_EPI) { if (wr == 0) PG8_BAR; }
        if constexpr (!Epi::AFTER_DRAIN) { E(acc, cur, wr, wc, fr, fq); S.done(cur); }
        if (!has_next) break;
#pragma unroll
        for (int a = 0; a < 2; ++a)
#pragma unroll
            for (int b = 0; b < 2; ++b)
#pragma unroll
                for (int m = 0; m < 4; ++m)
#pragma unroll
                    for (int n = 0; n < 2; ++n) acc[a][b][m][n] = (f32x4){0.f, 0.f, 0.f, 0.f};
        cur = nxt; cA = nA; cB = nB; ++ui;
        if constexpr (ALIGN_EPI) { if (wr == 1) PG8_BAR; }
    }
    PG8_WAIT_V(0);
    if constexpr (!ALIGN_EPI) { if (wr == 0) PG8_BAR; }
    PG8_BAR;
    if constexpr (Epi::AFTER_DRAIN) { E.fused(acc, cur, wr, wc, fr, fq, lds, wid, lane); S.done(cur); }
#undef PG8_SA
#undef PG8_SB
#undef PG8_STAGE
#undef PG8_LDA
#undef PG8_LDB
#undef PG8_MMA
#undef PG8_WAIT_V
#undef PG8_WAIT_L
#undef PG8_BAR
#undef PG8_SCHED
}
}
#define LAS __attribute__((address_space(3)))
#define XB_TMO      128
#define XB_XCNT(j)  (256  + 64 * (j))
#define XB_XSUB(j)  (1280 + 64 * (j))
#define XB_XGEN(j)  (2304 + 64 * (j))
#define XB_TOP      3328
#define XB_TOPGEN   3392
#define XCD_BAR_WORDS 3456
#define XB_SPIN_CAP (1u << 18)

__device__ __forceinline__ unsigned xb_ld(unsigned* p)              { return __hip_atomic_load(p, __ATOMIC_RELAXED, __HIP_MEMORY_SCOPE_AGENT); }
__device__ __forceinline__ unsigned xb_add(unsigned* p, unsigned v) { return __hip_atomic_fetch_add(p, v, __ATOMIC_RELAXED, __HIP_MEMORY_SCOPE_AGENT); }
__device__ __forceinline__ unsigned xb_xcc_id() { return (unsigned)__builtin_amdgcn_s_getreg((3 << 11) | 20) & 0xFu; }
#define XB_SPIN(cond, bar) do { unsigned _sp = 0; while (cond) { __builtin_amdgcn_s_sleep(1); \
    if ((++_sp & 255u) == 0u) { if (xb_ld(&(bar)[XB_TMO])) break; if (_sp > XB_SPIN_CAP) { atomicAdd(&(bar)[XB_TMO], 1u); break; } } } } while (0)

struct XcdBarrier {
    unsigned* bar; unsigned x;
    volatile LAS unsigned* st;
};

__device__ __forceinline__ XcdBarrier xcd_barrier_post(unsigned* bar, volatile LAS unsigned* st) {
    XcdBarrier b; b.bar = bar; b.x = xb_xcc_id(); b.st = st;
    if (threadIdx.x == 0) (void)xb_add(&bar[XB_XCNT(b.x)], 1u);
    return b;
}
__device__ __forceinline__ void xcd_barrier_complete(unsigned* bar, unsigned x, unsigned& nloc, unsigned& nx) {
    const unsigned G = gridDim.x * gridDim.y * gridDim.z;
    unsigned sum, cnt, mine, sp = 0u;
    for (;;) {
        sum = 0u; cnt = 0u; mine = 0u;
#pragma unroll
        for (unsigned j = 0; j < 16; ++j) { const unsigned c = xb_ld(&bar[XB_XCNT(j)]); sum += c; cnt += (c > 0u) ? 1u : 0u; mine = (j == x) ? c : mine; }
        if (sum == G) break;
        __builtin_amdgcn_s_sleep(1);
        if ((++sp & 255u) == 0u) { if (xb_ld(&bar[XB_TMO])) break; if (sp > XB_SPIN_CAP) { atomicAdd(&bar[XB_TMO], 1u); break; } }
    }
    nloc = mine > 0u ? mine : 1u; nx = cnt > 0u ? cnt : 1u;
}

__device__ __forceinline__ void xcd_barrier(const XcdBarrier& b) {
    asm volatile("s_waitcnt vmcnt(0)" ::: "memory");
    __syncthreads();
    if (threadIdx.x == 0) {
        unsigned* bar = b.bar;
        __builtin_amdgcn_s_waitcnt(0);
        unsigned nloc = b.st[0], nx = b.st[1];
        if (nloc == 0u) { xcd_barrier_complete(bar, b.x, nloc, nx); b.st[0] = nloc; b.st[1] = nx; }
        const unsigned old = xb_add(&bar[XB_XSUB(b.x)], 1u);
        const unsigned gen = old / nloc;
        if (old + 1u == (gen + 1u) * nloc) {
            __builtin_amdgcn_fence(__ATOMIC_RELEASE, "agent");
            asm volatile("s_waitcnt vmcnt(0)" ::: "memory");
            const unsigned og = xb_add(&bar[XB_TOP], 1u);
            const unsigned tg = og / nx;
            if (og + 1u == (tg + 1u) * nx) xb_add(&bar[XB_TOPGEN], 1u);
            else XB_SPIN(xb_ld(&bar[XB_TOPGEN]) == tg, bar);
            __builtin_amdgcn_fence(__ATOMIC_ACQUIRE, "agent");
            xb_add(&bar[XB_XGEN(b.x)], 1u);
            asm volatile("s_waitcnt vmcnt(0)" ::: "memory");
        } else {
            XB_SPIN(xb_ld(&bar[XB_XGEN(b.x)]) == gen, bar);
            __builtin_amdgcn_fence(__ATOMIC_ACQUIRE, "agent");
            asm volatile("s_waitcnt vmcnt(0)" ::: "memory");
        }
    }
    __syncthreads();
}

#define XL_CNT(j)  (3584 + 64 * (j))
#define XL_DEP(j)  (3584 + 64 * (j) + 32)
__device__ __forceinline__ void xcd_local_barrier(unsigned* bar, unsigned x, unsigned nloc) {
    asm volatile("s_waitcnt vmcnt(0)" ::: "memory");
    __syncthreads();
    if (threadIdx.x == 0) {
        __builtin_amdgcn_s_waitcnt(0);
        const unsigned old = xb_add(&bar[XL_CNT(x)], 1u);
        const unsigned target = (old / nloc + 1u) * nloc;
        XB_SPIN(xb_ld(&bar[XL_CNT(x)]) < target, bar);
        __builtin_amdgcn_fence(__ATOMIC_ACQUIRE, "agent");
        asm volatile("s_waitcnt vmcnt(0)" ::: "memory");
    }
    __syncthreads();
}

__device__ __forceinline__ void xl_signal(unsigned* word) {
    asm volatile("s_waitcnt vmcnt(0)" ::: "memory");
    __syncthreads();
    if (threadIdx.x == 0) { __builtin_amdgcn_s_waitcnt(0); (void)xb_add(word, 1u); }
}
__device__ __forceinline__ void xl_wait(unsigned* word, unsigned want, unsigned* bar) {
    __syncthreads();
    if (threadIdx.x == 0) { XB_SPIN(xb_ld(word) < want, bar); __builtin_amdgcn_fence(__ATOMIC_ACQUIRE, "agent"); asm volatile("s_waitcnt vmcnt(0)" ::: "memory"); }
    __syncthreads();
}

constexpr int NWAVES = 8;
constexpr int BATCH = 16, SEQ = 2048, D = 1024, FF = 2816, M = BATCH * SEQ;
constexpr int HG_HEADS = 8, HG_DK = 128, HG_CHUNK = 64, NCHUNK = SEQ / HG_CHUNK;
constexpr int ATT_HEADS = 16, ATT_KVH = 2, ATT_HD = 64, WINDOW = 128, NBLK = SEQ / WINDOW;
constexpr float EPS = 1e-6f;

#ifndef PROBE_DUP
#define PROBE_DUP 0
#endif
#ifndef MK_ONE_LAUNCH
#define MK_ONE_LAUNCH 1
#endif

constexpr size_t MiB = 1u << 20;
constexpr size_t SZ_WGU = (size_t)2 * FF * D * 2, SZ_WD = (size_t)D * FF * 2;
constexpr size_t WS_MISC = 0;
constexpr size_t WS_BAR = 512 * 1024, BAR_BYTES = 16384;
constexpr size_t WS_WGU = 1 * MiB;
constexpr size_t WS_WD = WS_WGU + 4 * SZ_WGU;
constexpr size_t WS_WIN = WS_WD + 4 * SZ_WD;
constexpr size_t WS_WHO = WS_WIN + (size_t)4096 * D * 2;
constexpr size_t WS_WKV = WS_WHO + (size_t)D * D * 2;
constexpr size_t WS_WQ = WS_WKV + (size_t)256 * D * 2;
constexpr size_t WS_WAO = WS_WQ + (size_t)D * D * 2;
constexpr size_t WS_WEND = WS_WAO + (size_t)D * D * 2;
constexpr size_t WS_HB = 88 * MiB;
constexpr size_t WS_SSQ = WS_HB + 64 * MiB;
constexpr size_t WS_KB = WS_SSQ + 2 * MiB;
constexpr size_t WS_VB = WS_KB + 8 * MiB;
constexpr size_t WS_R = WS_VB + 8 * MiB;
constexpr size_t WS_ACT = WS_R;
constexpr size_t WS_HQ = WS_R, WS_HLOGF = WS_R + 64 * MiB, WS_HV = WS_R + 192 * MiB, WS_HG = WS_R + 256 * MiB;
constexpr size_t WS_QA = WS_R + 192 * MiB;
constexpr size_t WS_END = WS_R + 320 * MiB;
static_assert(WS_WEND <= WS_HB && (size_t)M * FF * 2 <= 320 * MiB && WS_END <= 512 * MiB, "d_ws map");

constexpr int LDS_BYTES = 147456;

typedef unsigned short bf16;
typedef unsigned v4u __attribute__((ext_vector_type(4)));
typedef unsigned v2u __attribute__((ext_vector_type(2)));
typedef float f32x4 __attribute__((ext_vector_type(4)));
typedef float f32x16 __attribute__((ext_vector_type(16)));
typedef short bf16x8 __attribute__((ext_vector_type(8)));
#define LDS_WAIT() asm volatile("s_waitcnt lgkmcnt(0)" ::: "memory")
__device__ __forceinline__ unsigned f2bf(float f) { unsigned u = __builtin_bit_cast(unsigned, f); return (u + 0x7fffu + ((u >> 16) & 1u)) >> 16; }
__device__ __forceinline__ unsigned pk2(float lo, float hi) { return pg8::cvt_pk_bf16(lo, hi); }
__device__ __forceinline__ float bf2f(unsigned short b) { return __builtin_bit_cast(float, (unsigned)b << 16); }
__device__ __forceinline__ float wave_sum(float v) {
#pragma unroll
    for (int o = 1; o < 64; o <<= 1) v += __shfl_xor(v, o);
    return v;
}

template <int MODE> __device__ __forceinline__ int remap_row(int n) {
    if (MODE == 1) { const int bj = n >= FF ? 1 : 0, r = n - bj * FF, t = r >> 7, j = r & 127; return 256 * t + 128 * bj + j; }
    if (MODE == 2) { const int head = n >> 6, d = n & 63, pn = head >> 2, wc = head & 3, bj = d >> 5, j = d & 31; return 256 * pn + 128 * bj + 32 * wc + j; }
    return n;
}
struct Args {
    const float* x; const float* ffn_norm_g; const float* ffn_w_gate_up; const float* ffn_w_down; const float* mix_norm_g; const float* hgrn_w_in; const float* hgrn_lb_logits;
    const float* hgrn_onorm_g; const float* hgrn_w_out; const float* kv_norm_g; const float* kv_w; const float* k_norm_g; const float* attn_w_q; const float* q_norm_g;
    const float* attn_sinks; const float* attn_w_out;
    float* out; unsigned char* ws; int ph_lo, ph_hi;
};

struct TItem { const float* W; const float* gk; bf16* WT; int K, N, mode, k0, n0; };
__device__ __forceinline__ int remap_rt(int mode, int n) { return mode == 1 ? remap_row<1>(n) : (mode == 2 ? remap_row<2>(n) : n); }
template <int SET> __device__ __forceinline__ TItem titem(const Args& a, int it) {
    unsigned char* ws = a.ws; TItem t; int r = it;
    constexpr int I_GU = (D / 64) * (2 * FF / 32), I_D = (FF / 64) * (D / 32), I_IN = (D / 64) * (4096 / 32), I_SQ = (D / 64) * (D / 32), I_KV = (D / 64) * (256 / 32);
    if (SET == 0) {
        if (r < I_GU) { t.W = a.ffn_w_gate_up; t.gk = a.ffn_norm_g; t.WT = (bf16*)(ws + WS_WGU); t.K = D; t.N = 2 * FF; t.mode = 1; }
        else if ((r -= I_GU) < I_D) { t.W = a.ffn_w_down; t.gk = nullptr; t.WT = (bf16*)(ws + WS_WD); t.K = FF; t.N = D; t.mode = 0; }
        else if ((r -= I_D) < I_IN) { t.W = a.hgrn_w_in; t.gk = a.mix_norm_g; t.WT = (bf16*)(ws + WS_WIN); t.K = D; t.N = 4096; t.mode = 0; }
        else { r -= I_IN; t.W = a.hgrn_w_out; t.gk = nullptr; t.WT = (bf16*)(ws + WS_WHO); t.K = D; t.N = D; t.mode = 0; }
    } else {
        if (r < 3 * I_GU) { const int l = 1 + r / I_GU; r -= (l - 1) * I_GU; t.W = a.ffn_w_gate_up + (size_t)l * D * 2 * FF; t.gk = a.ffn_norm_g + l * D; t.WT = (bf16*)(ws + WS_WGU + l * SZ_WGU); t.K = D; t.N = 2 * FF; t.mode = 1; }
        else if ((r -= 3 * I_GU) < 3 * I_D) { const int l = 1 + r / I_D; r -= (l - 1) * I_D; t.W = a.ffn_w_down + (size_t)l * FF * D; t.gk = nullptr; t.WT = (bf16*)(ws + WS_WD + l * SZ_WD); t.K = FF; t.N = D; t.mode = 0; }
        else if ((r -= 3 * I_D) < I_KV) { t.W = a.kv_w; t.gk = a.kv_norm_g; t.WT = (bf16*)(ws + WS_WKV); t.K = D; t.N = 256; t.mode = 2; }
        else if ((r -= I_KV) < I_SQ) { t.W = a.attn_w_q; t.gk = a.mix_norm_g + D; t.WT = (bf16*)(ws + WS_WQ); t.K = D; t.N = D; t.mode = 2; }
        else { r -= I_SQ; t.W = a.attn_w_out; t.gk = nullptr; t.WT = (bf16*)(ws + WS_WAO); t.K = D; t.N = D; t.mode = 0; }
    }
    const int nblk = t.N / 32, kb = r / nblk, nb = r - kb * nblk; t.k0 = 64 * kb; t.n0 = 32 * nb;
    return t;
}
struct TRegs { float r[32]; f32x4 g0, g1; };
__device__ __forceinline__ void tload(const TItem& t, int lane, TRegs& q) {
    const float* p = t.W + (size_t)(t.k0 + (lane >> 5)) * t.N + t.n0 + (lane & 31);
#pragma unroll
    for (int i = 0; i < 32; ++i) q.r[i] = p[(size_t)(2 * i) * t.N];
    if (t.gk) { q.g0 = *(const f32x4*)(t.gk + t.k0 + 8 * (lane & 7)); q.g1 = *(const f32x4*)(t.gk + t.k0 + 8 * (lane & 7) + 4); }
    else { q.g0 = (f32x4){1.f, 1.f, 1.f, 1.f}; q.g1 = q.g0; }
}
__device__ __forceinline__ void tfinish(const TItem& t, LAS float* scr, int lane, const TRegs& q) {
#pragma unroll
    for (int i = 0; i < 32; ++i) scr[(2 * i + (lane >> 5)) * 33 + (lane & 31)] = q.r[i];
    LDS_WAIT(); asm volatile("" ::: "memory");
    const int c = lane & 7;
#pragma unroll
    for (int j = 0; j < 4; ++j) { const int n = (lane >> 3) + 8 * j; const LAS float* s = scr + (8 * c) * 33 + n;
        v4u o; o.x = pk2(s[0 * 33] * q.g0[0], s[1 * 33] * q.g0[1]); o.y = pk2(s[2 * 33] * q.g0[2], s[3 * 33] * q.g0[3]); o.z = pk2(s[4 * 33] * q.g1[0], s[5 * 33] * q.g1[1]); o.w = pk2(s[6 * 33] * q.g1[2], s[7 * 33] * q.g1[3]);
        *(v4u*)(t.WT + (size_t)remap_rt(t.mode, t.n0 + n) * t.K + t.k0 + 8 * c) = o; }
    LDS_WAIT(); asm volatile("" ::: "memory");
}
template <int SET> __device__ __forceinline__ void p0_transposes(const Args& a, LAS unsigned char* lds, int widx, int nw, int wave, int lane) {
    LAS float* scr = (LAS float*)(lds + wave * 16384);
    const int gw = widx * NWAVES + wave, NGW = nw * NWAVES;
    constexpr int I_GU = (D / 64) * (2 * FF / 32), I_D = (FF / 64) * (D / 32), I_IN = (D / 64) * (4096 / 32), I_SQ = (D / 64) * (D / 32), I_KV = (D / 64) * (256 / 32);
    constexpr int NITEMS = SET == 0 ? I_GU + I_D + I_IN + I_SQ : 3 * I_GU + 3 * I_D + 2 * I_SQ + I_KV;
    int it = gw; if (it >= NITEMS) return;
    TItem ta = titem<SET>(a, it), tb = ta; TRegs ra, rb;
    tload(ta, lane, ra);
    for (;;) {
        const int i1 = it + NGW; const bool h1 = i1 < NITEMS;
        if (h1) { tb = titem<SET>(a, i1); tload(tb, lane, rb); }
        tfinish(ta, scr, lane, ra);
        if (!h1) break;
        const int i2 = i1 + NGW; const bool h2 = i2 < NITEMS;
        if (h2) { ta = titem<SET>(a, i2); tload(ta, lane, ra); }
        tfinish(tb, scr, lane, rb);
        if (!h2) break;
        it = i2;
    }
}
__device__ __forceinline__ void p0_prologue(const Args& a, LAS unsigned char* lds, int bid, int G, int wave, int lane) {
    p0_transposes<0>(a, lds, bid, G, wave, lane);
    const int gw = bid * NWAVES + wave, NGW = G * NWAVES;
    unsigned char* ws = a.ws;
    bf16* hb = (bf16*)(ws + WS_HB); float* ssq = (float*)(ws + WS_SSQ);
    for (int m = gw; m < M; m += 2 * NGW) {
        const int m2 = m + NGW;
        const bool has2 = m2 < M;
        const f32x4* xr = (const f32x4*)(a.x + (size_t)m * D) + lane; const f32x4* xr2 = (const f32x4*)(a.x + (size_t)(has2 ? m2 : m) * D) + lane;
        f32x4 v[4], v2[4]; float s = 0.f, s2 = 0.f;
#pragma unroll
        for (int j = 0; j < 4; ++j) { v[j] = xr[64 * j]; v2[j] = xr2[64 * j]; }
#pragma unroll
        for (int j = 0; j < 4; ++j) { s += (v[j].x * v[j].x + v[j].y * v[j].y) + (v[j].z * v[j].z + v[j].w * v[j].w); s2 += (v2[j].x * v2[j].x + v2[j].y * v2[j].y) + (v2[j].z * v2[j].z + v2[j].w * v2[j].w); }
        s = wave_sum(s); s2 = wave_sum(s2);
        unsigned long long* o8 = (unsigned long long*)(hb + (size_t)m * D) + lane;
#pragma unroll
        for (int j = 0; j < 4; ++j) o8[64 * j] = (unsigned long long)pk2(v[j].x, v[j].y) | ((unsigned long long)pk2(v[j].z, v[j].w) << 32);
        if (lane < 16) ssq[(size_t)m * 16 + lane] = lane == 0 ? s : 0.f;
        if (has2) {
            unsigned long long* o82 = (unsigned long long*)(hb + (size_t)m2 * D) + lane;
#pragma unroll
            for (int j = 0; j < 4; ++j) o82[64 * j] = (unsigned long long)pk2(v2[j].x, v2[j].y) | ((unsigned long long)pk2(v2[j].z, v2[j].w) << 32);
            if (lane < 16) ssq[(size_t)m2 * 16 + lane] = lane == 0 ? s2 : 0.f;
        }
    }
    float* lbv = (float*)(ws + WS_MISC); float* rope = (float*)(ws + WS_MISC + 65536);
    for (int i = gw * 64 + lane; i < 1024; i += NGW * 64) { const float l0 = a.hgrn_lb_logits[i], l1 = a.hgrn_lb_logits[1024 + i]; lbv[i] = 1.0f / (1.0f + expf(l1 - l0)); }
    for (int i = gw * 64 + lane; i < 2048 * 8; i += NGW * 64) { const int pos = i >> 3, k = i & 7;
        const float inv_freq = powf(500000.0f, -(float)k * 0.125f); const float ang = (float)pos * inv_freq;
        rope[2 * i] = cosf(ang); rope[2 * i + 1] = sinf(ang); }
}

constexpr int HQE = 0, HKE = 17408, HKDT = 34816, HVT = 53248, HSC = 71680, HBEND = 80896, HCUM = 81408, HNRM = 85504;
constexpr int PQ = 272, PT = 144;
typedef float f32x2 __attribute__((ext_vector_type(2)));
typedef _Float16 h2v __attribute__((ext_vector_type(2)));
__device__ __forceinline__ void hgrn_phase(LAS unsigned char* lds, const bf16* qb, const float* fgt, const bf16* vb, const bf16* gb, bf16* og, const float* onorm_g, int G, int bid, int tid, int w, int lane, unsigned* xbar = nullptr, unsigned xcc_ = 0u, int midc = -1) {
    const int g = lane >> 4, lr = lane & 15;
    const int cp = lane, grp = w;
#define HG_FINALIZE(ROW0) do { \
        _Pragma("unroll") for (int t4 = 0; t4 < 4; ++t4) { const int t = 16 * t4 + lr; const f32x4 na = *(const LAS f32x4*)(lds + HNRM + t * 32), nb = *(const LAS f32x4*)(lds + HNRM + t * 32 + 16); \
            const float tot2 = ((na[0] + na[1]) + (na[2] + na[3])) + ((nb[0] + nb[1]) + (nb[2] + nb[3])); const float r = 1.0f / sqrtf(tot2 * (1.0f / 128.0f) + EPS); \
            const float g0 = bf2f((unsigned short)(gt[t4].x & 0xffffu)), g1 = bf2f((unsigned short)(gt[t4].x >> 16)), g2 = bf2f((unsigned short)(gt[t4].y & 0xffffu)), g3 = bf2f((unsigned short)(gt[t4].y >> 16)); \
            v2u ov; ov.x = pk2(o[t4][0] * r * gnv[0] * g0, o[t4][1] * r * gnv[1] * g1); ov.y = pk2(o[t4][2] * r * gnv[2] * g2, o[t4][3] * r * gnv[3] * g3); \
            *(v2u*)(og + ((ROW0) + t) * 1024 + colbase + 16 * w + 4 * g) = ov; } } while (0)
    for (int item = bid; item < BATCH * HG_HEADS; item += G) {
        const int b = item >> 3, head = item & 7, colbase = head * 128;
        const size_t rbase = (size_t)b * SEQ;
        f32x4 S[8];
#pragma unroll
        for (int j = 0; j < 8; ++j) S[j] = (f32x4){0.f, 0.f, 0.f, 0.f};
        const f32x4 gnv = *(const f32x4*)(onorm_g + 16 * w + 4 * g);
        f32x2 nf[8]; unsigned nq[8], nv[8];
        { const size_t base = (rbase + 8 * grp) * 1024 + colbase + 2 * cp;
#pragma unroll
          for (int i = 0; i < 8; ++i) { nf[i] = __builtin_convertvector(*(const h2v*)((const _Float16*)fgt + base + (size_t)i * 1024), f32x2); nq[i] = *(const unsigned*)(qb + base + (size_t)i * 1024); nv[i] = *(const unsigned*)(vb + base + (size_t)i * 1024); } }
        f32x4 o[4]; v2u gt[4];
#pragma unroll
        for (int t4 = 0; t4 < 4; ++t4) { o[t4] = (f32x4){0.f, 0.f, 0.f, 0.f}; gt[t4] = (v2u){0u, 0u}; }
        for (int c = 0; c < NCHUNK; ++c) {
            if (c == midc) xcd_local_barrier(xbar, xcc_, 32u);
            const size_t row0 = rbase + c * HG_CHUNK;
            f32x2 P[8]; { float p0 = 1.f, p1 = 1.f;
#pragma unroll
              for (int i = 0; i < 8; ++i) { p0 *= nf[i].x; p1 *= nf[i].y; P[i] = (f32x2){p0, p1}; }
              *(LAS f32x2*)(lds + HCUM + (grp * 128 + 2 * cp) * 4) = (f32x2){p0, p1}; }
            LDS_WAIT(); __builtin_amdgcn_s_barrier(); asm volatile("" ::: "memory");
            float pre0 = 1.f, pre1 = 1.f, tot0 = 1.f, tot1 = 1.f;
#pragma unroll
            for (int gg = 0; gg < 8; ++gg) { const f32x2 t = *(const LAS f32x2*)(lds + HCUM + (gg * 128 + 2 * cp) * 4); if (gg < grp) { pre0 *= t.x; pre1 *= t.y; } tot0 *= t.x; tot1 *= t.y; }
            float kd0[8], kd1[8];
#pragma unroll
            for (int i = 0; i < 8; ++i) {
                const float eb0 = pre0 * P[i].x, eb1 = pre1 * P[i].y, k0 = 1.0f - nf[i].x, k1 = 1.0f - nf[i].y;
                const float q0 = bf2f((unsigned short)(nq[i] & 0xffffu)), q1 = bf2f((unsigned short)(nq[i] >> 16));
                const float ke0 = k0 * __builtin_amdgcn_rcpf(eb0), ke1 = k1 * __builtin_amdgcn_rcpf(eb1);
                const int s = 8 * grp + i;
                *(LAS unsigned*)(lds + HQE + s * PQ + cp * 4) = pk2(q0 * eb0, q1 * eb1);
                *(LAS unsigned*)(lds + HKE + s * PQ + cp * 4) = pk2(ke0, ke1);
                kd0[i] = ke0 * tot0; kd1[i] = ke1 * tot1;
            }
            { v4u a, bq, va, vq;
              a.x = pk2(kd0[0], kd0[1]); a.y = pk2(kd0[2], kd0[3]); a.z = pk2(kd0[4], kd0[5]); a.w = pk2(kd0[6], kd0[7]);
              bq.x = pk2(kd1[0], kd1[1]); bq.y = pk2(kd1[2], kd1[3]); bq.z = pk2(kd1[4], kd1[5]); bq.w = pk2(kd1[6], kd1[7]);
              va.x = (nv[0] & 0xffffu) | (nv[1] << 16); va.y = (nv[2] & 0xffffu) | (nv[3] << 16); va.z = (nv[4] & 0xffffu) | (nv[5] << 16); va.w = (nv[6] & 0xffffu) | (nv[7] << 16);
              vq.x = (nv[0] >> 16) | (nv[1] & 0xffff0000u); vq.y = (nv[2] >> 16) | (nv[3] & 0xffff0000u); vq.z = (nv[4] >> 16) | (nv[5] & 0xffff0000u); vq.w = (nv[6] >> 16) | (nv[7] & 0xffff0000u);
              *(LAS v4u*)(lds + HKDT + (2 * cp) * PT + grp * 16) = a; *(LAS v4u*)(lds + HKDT + (2 * cp + 1) * PT + grp * 16) = bq;
              *(LAS v4u*)(lds + HVT + (2 * cp) * PT + grp * 16) = va; *(LAS v4u*)(lds + HVT + (2 * cp + 1) * PT + grp * 16) = vq; }
            if (grp == 0) *(LAS f32x2*)(lds + HBEND + 2 * cp * 4) = (f32x2){tot0, tot1};
            LDS_WAIT(); __builtin_amdgcn_s_barrier(); asm volatile("" ::: "memory");
            if (c > 0) HG_FINALIZE(row0 - HG_CHUNK);
            __builtin_amdgcn_sched_barrier(0);
            if (c + 1 < NCHUNK) { const size_t base = (row0 + HG_CHUNK + 8 * grp) * 1024 + colbase + 2 * cp;
#pragma unroll
              for (int i = 0; i < 8; ++i) { nf[i] = __builtin_convertvector(*(const h2v*)((const _Float16*)fgt + base + (size_t)i * 1024), f32x2); nq[i] = *(const unsigned*)(qb + base + (size_t)i * 1024); nv[i] = *(const unsigned*)(vb + base + (size_t)i * 1024); } }
#pragma unroll
            for (int t4 = 0; t4 < 4; ++t4) gt[t4] = *(const v2u*)(gb + (row0 + 16 * t4 + lr) * 1024 + colbase + 16 * w + 4 * g);
            __builtin_amdgcn_sched_barrier(0);
            { const int tt = w >> 1; const int st0 = 2 * (w & 1);
              bf16x8 af[4], bfr[2][4];
#pragma unroll
              for (int kk = 0; kk < 4; ++kk) { af[kk] = *(const LAS bf16x8*)(lds + HQE + (16 * tt + lr) * PQ + (32 * kk + 8 * g) * 2);
                  bfr[0][kk] = *(const LAS bf16x8*)(lds + HKE + (16 * st0 + lr) * PQ + (32 * kk + 8 * g) * 2); bfr[1][kk] = *(const LAS bf16x8*)(lds + HKE + (16 * (st0 + 1) + lr) * PQ + (32 * kk + 8 * g) * 2); }
              __builtin_amdgcn_sched_barrier(0);
#pragma unroll
              for (int s2 = 0; s2 < 2; ++s2) { const int st = st0 + s2; f32x4 cacc = (f32x4){0.f, 0.f, 0.f, 0.f};
                if (st <= tt) {
#pragma unroll
                    for (int kk = 0; kk < 4; ++kk) cacc = __builtin_amdgcn_mfma_f32_16x16x32_bf16(af[kk], bfr[s2][kk], cacc, 0, 0, 0);
                    if (st == tt) {
#pragma unroll
                        for (int e = 0; e < 4; ++e) if (lr > 4 * g + e) cacc[e] = 0.f;
                    }
                }
#pragma unroll
                for (int e = 0; e < 4; ++e) *(LAS unsigned short*)(lds + HSC + (16 * tt + 4 * g + e) * PT + (16 * st + lr) * 2) = (unsigned short)f2bf(cacc[e]);
              } }
            __builtin_amdgcn_sched_barrier(0);
#pragma unroll
            for (int t4 = 0; t4 < 4; ++t4) o[t4] = (f32x4){0.f, 0.f, 0.f, 0.f};
            {
                bf16x8 sf[4]; v2u qlo[4][4], qhi[4][4];
#pragma unroll
                for (int t4 = 0; t4 < 4; ++t4)
#pragma unroll
                    for (int kk = 0; kk < 4; ++kk) { qlo[t4][kk] = *(const LAS v2u*)(lds + HQE + (16 * t4 + lr) * PQ + (32 * kk + 4 * g) * 2); qhi[t4][kk] = *(const LAS v2u*)(lds + HQE + (16 * t4 + lr) * PQ + (32 * kk + 16 + 4 * g) * 2); }
#pragma unroll
                for (int kk = 0; kk < 4; ++kk) { v4u p; p.x = pk2(S[2 * kk][0], S[2 * kk][1]); p.y = pk2(S[2 * kk][2], S[2 * kk][3]); p.z = pk2(S[2 * kk + 1][0], S[2 * kk + 1][1]); p.w = pk2(S[2 * kk + 1][2], S[2 * kk + 1][3]);
                    sf[kk] = __builtin_bit_cast(bf16x8, p); }
                __builtin_amdgcn_sched_barrier(0);
#pragma unroll
                for (int kk = 0; kk < 4; ++kk)
#pragma unroll
                    for (int t4 = 0; t4 < 4; ++t4) {
                        v4u q4; q4.x = qlo[t4][kk].x; q4.y = qlo[t4][kk].y; q4.z = qhi[t4][kk].x; q4.w = qhi[t4][kk].y;
                        o[t4] = __builtin_amdgcn_mfma_f32_16x16x32_bf16(sf[kk], __builtin_bit_cast(bf16x8, q4), o[t4], 0, 0, 0);
                    }
            }
            __builtin_amdgcn_sched_barrier(0);
            bf16x8 vf[2];
            {
                bf16x8 kf[8][2]; f32x4 dec[8];
#pragma unroll
                for (int ks = 0; ks < 2; ++ks) vf[ks] = *(const LAS bf16x8*)(lds + HVT + (16 * w + lr) * PT + (32 * ks + 8 * g) * 2);
#pragma unroll
                for (int j = 0; j < 8; ++j) { dec[j] = *(const LAS f32x4*)(lds + HBEND + (16 * j + 4 * g) * 4);
#pragma unroll
                    for (int ks = 0; ks < 2; ++ks) kf[j][ks] = *(const LAS bf16x8*)(lds + HKDT + (16 * j + lr) * PT + (32 * ks + 8 * g) * 2); }
                __builtin_amdgcn_sched_barrier(0);
#pragma unroll
                for (int j = 0; j < 8; ++j) S[j] = S[j] * dec[j];
#pragma unroll
                for (int ks = 0; ks < 2; ++ks)
#pragma unroll
                    for (int j = 0; j < 8; ++j) S[j] = __builtin_amdgcn_mfma_f32_16x16x32_bf16(kf[j][ks], vf[ks], S[j], 0, 0, 0);
            }
            __builtin_amdgcn_sched_barrier(0);
            LDS_WAIT(); __builtin_amdgcn_s_barrier(); asm volatile("" ::: "memory");
            {
                bf16x8 scf[4][2];
#pragma unroll
                for (int t4 = 0; t4 < 4; ++t4)
#pragma unroll
                    for (int ks = 0; ks < 2; ++ks) if (2 * ks <= t4) scf[t4][ks] = *(const LAS bf16x8*)(lds + HSC + (16 * t4 + lr) * PT + (32 * ks + 8 * g) * 2);
                __builtin_amdgcn_sched_barrier(0);
#pragma unroll
                for (int ks = 0; ks < 2; ++ks)
#pragma unroll
                    for (int t4 = 0; t4 < 4; ++t4) if (2 * ks <= t4) o[t4] = __builtin_amdgcn_mfma_f32_16x16x32_bf16(vf[ks], scf[t4][ks], o[t4], 0, 0, 0);
            }
#pragma unroll
            for (int t4 = 0; t4 < 4; ++t4) { float ss = (o[t4][0] * o[t4][0] + o[t4][1] * o[t4][1]) + (o[t4][2] * o[t4][2] + o[t4][3] * o[t4][3]); ss += __shfl_xor(ss, 16); ss += __shfl_xor(ss, 32);
                if (g == 0) *(LAS float*)(lds + HNRM + ((16 * t4 + lr) * 8 + w) * 4) = ss; }
        }
        LDS_WAIT(); __builtin_amdgcn_s_barrier(); asm volatile("" ::: "memory");
        HG_FINALIZE(rbase + (NCHUNK - 1) * HG_CHUNK);
    }
#undef HG_FINALIZE
}

constexpr int AKB = 0, APK = 144, AVT = 36864, APV = 528;
__device__ __forceinline__ void attn_phase(LAS unsigned char* lds, const bf16* qa, const bf16* kb, const bf16* vb, bf16* ao, const float* sinks, int G, int bid, int iend, int tid, int w, int lane) {
    const int h = lane >> 5, tl = lane & 31;
    for (int item = bid; item < iend; item += G) {
        const int b = item >> 5, blk = (item >> 1) & 15, kvh = item & 1;
        __syncthreads();
        { const int r = tid >> 1, hf = tid & 1;
          const int d = tid >> 3, seg = tid & 7;
          v4u kx[4], vx[4];
          const bool lo_ok = blk > 0 || r >= 128;
          if (lo_ok) { const size_t grow = (size_t)b * SEQ + (blk - 1) * WINDOW + r; const v4u* kp = (const v4u*)(kb + grow * 128 + kvh * 64 + hf * 32);
#pragma unroll
              for (int i = 0; i < 4; ++i) kx[i] = kp[i]; }
#pragma unroll
          for (int pb = 0; pb < 2; ++pb) if (blk > 0 || pb == 1) { const v4u* vp = (const v4u*)(vb + ((((size_t)b * NBLK + (blk - 1 + pb)) * ATT_KVH + kvh) * 64 + d) * 128 + seg * 16); vx[2 * pb] = vp[0]; vx[2 * pb + 1] = vp[1]; }
          if (lo_ok) {
#pragma unroll
              for (int i = 0; i < 4; ++i) *(LAS v4u*)(lds + AKB + r * APK + (hf * 32 + 8 * i) * 2) = kx[i]; }
#pragma unroll
          for (int pb = 0; pb < 2; ++pb) if (blk > 0 || pb == 1) { *(LAS v4u*)(lds + AVT + d * APV + (pb * 128 + seg * 16) * 2) = vx[2 * pb]; *(LAS v4u*)(lds + AVT + d * APV + (pb * 128 + seg * 16 + 8) * 2) = vx[2 * pb + 1]; }
        }
        __syncthreads();
        const int head = kvh * 8 + w; const float sink = sinks[head] * 1.4426950408889634f;
        bf16x8 qn[4];
        { const size_t qrow0 = (size_t)b * SEQ + blk * WINDOW + tl;
#pragma unroll
          for (int kk = 0; kk < 4; ++kk) qn[kk] = *(const bf16x8*)(qa + qrow0 * 1024 + head * 64 + 16 * kk + 8 * h); }
#pragma unroll 1
        for (int tq = 0; tq < 4; ++tq) {
            const size_t qrow = (size_t)b * SEQ + blk * WINDOW + 32 * tq + tl;
            bf16x8 qf[4];
#pragma unroll
            for (int kk = 0; kk < 4; ++kk) qf[kk] = qn[kk];
            if (tq < 3) {
#pragma unroll
                for (int kk = 0; kk < 4; ++kk) qn[kk] = *(const bf16x8*)(qa + (qrow + 32) * 1024 + head * 64 + 16 * kk + 8 * h);
            }
            const int jlo = blk == 0 ? 4 : 0;
            f32x16 S[5];
            bf16x8 kfr[2][4];
#pragma unroll
            for (int kk = 0; kk < 4; ++kk) kfr[0][kk] = *(const LAS bf16x8*)(lds + AKB + (32 * tq + tl) * APK + (16 * kk + 8 * h) * 2);
#pragma unroll
            for (int jj = 0; jj < 5; ++jj) {
                if (jj < 4) {
#pragma unroll
                    for (int kk = 0; kk < 4; ++kk) kfr[(jj + 1) & 1][kk] = *(const LAS bf16x8*)(lds + AKB + (32 * (tq + jj + 1) + tl) * APK + (16 * kk + 8 * h) * 2);
                }
                __builtin_amdgcn_sched_barrier(0);
#pragma unroll
                for (int e = 0; e < 16; ++e) S[jj][e] = 0.f;
#pragma unroll
                for (int kk = 0; kk < 4; ++kk) S[jj] = __builtin_amdgcn_mfma_f32_32x32x16_bf16(kfr[jj & 1][kk], qf[kk], S[jj], 0, 0, 0);
                __builtin_amdgcn_sched_barrier(0);
            }
#pragma unroll
            for (int e = 0; e < 16; ++e) { const int sl = (e & 3) + 8 * (e >> 2) + 4 * h; S[0][e] = (sl > tl) ? S[0][e] : -INFINITY; S[4][e] = (sl <= tl) ? S[4][e] : -INFINITY; }
            if (blk == 0) {
#pragma unroll
                for (int jj = 0; jj < 4; ++jj) if (tq + jj < 4) {
#pragma unroll
                    for (int e = 0; e < 16; ++e) S[jj][e] = -INFINITY; }
            }
            float mx = sink;
#pragma unroll
            for (int jj = 0; jj < 5; ++jj)
#pragma unroll
                for (int e = 0; e < 16; e += 2) mx = fmaxf(mx, fmaxf(S[jj][e], S[jj][e + 1]));
            mx = fmaxf(mx, __shfl_xor(mx, 32));
            float sum = 0.f;
#pragma unroll
            for (int jj = 0; jj < 5; ++jj)
#pragma unroll
                for (int e = 0; e < 16; ++e) { S[jj][e] = __builtin_amdgcn_exp2f(S[jj][e] - mx); sum += S[jj][e]; }
            sum += __shfl_xor(sum, 32); sum += __builtin_amdgcn_exp2f(sink - mx);
            const float inv = 1.0f / sum;
            f32x16 O[2];
#pragma unroll
            for (int dt = 0; dt < 2; ++dt)
#pragma unroll
                for (int e = 0; e < 16; ++e) O[dt][e] = 0.f;
            v2u vfr[2][2][2];
#define AT_VLOAD(buf, st) do { const int j_ = tq + ((st) >> 1), a_ = (st) & 1; _Pragma("unroll") for (int dt = 0; dt < 2; ++dt) { \
                vfr[buf][dt][0] = *(const LAS v2u*)(lds + AVT + (32 * dt + tl) * APV + (32 * j_ + 16 * a_ + 4 * h) * 2); vfr[buf][dt][1] = *(const LAS v2u*)(lds + AVT + (32 * dt + tl) * APV + (32 * j_ + 16 * a_ + 8 + 4 * h) * 2); } } while (0)
            AT_VLOAD(0, 0);
#pragma unroll
            for (int st = 0; st < 10; ++st) {
                const int jj = st >> 1, a2 = st & 1;
                if (st < 9) AT_VLOAD((st + 1) & 1, st + 1);
                __builtin_amdgcn_sched_barrier(0);
                if (tq + jj >= jlo) {
                    v4u pp; pp.x = pk2(S[jj][8 * a2 + 0], S[jj][8 * a2 + 1]); pp.y = pk2(S[jj][8 * a2 + 2], S[jj][8 * a2 + 3]); pp.z = pk2(S[jj][8 * a2 + 4], S[jj][8 * a2 + 5]); pp.w = pk2(S[jj][8 * a2 + 6], S[jj][8 * a2 + 7]);
                    const bf16x8 pf = __builtin_bit_cast(bf16x8, pp);
#pragma unroll
                    for (int dt = 0; dt < 2; ++dt) { v4u v4; v4.x = vfr[st & 1][dt][0].x; v4.y = vfr[st & 1][dt][0].y; v4.z = vfr[st & 1][dt][1].x; v4.w = vfr[st & 1][dt][1].y;
                        O[dt] = __builtin_amdgcn_mfma_f32_32x32x16_bf16(__builtin_bit_cast(bf16x8, v4), pf, O[dt], 0, 0, 0); }
                }
                __builtin_amdgcn_sched_barrier(0);
            }
#undef AT_VLOAD
#pragma unroll
            for (int dt = 0; dt < 2; ++dt)
#pragma unroll
                for (int rg = 0; rg < 4; ++rg) { v2u ov; ov.x = pk2(O[dt][4 * rg] * inv, O[dt][4 * rg + 1] * inv); ov.y = pk2(O[dt][4 * rg + 2] * inv, O[dt][4 * rg + 3] * inv);
                    *(v2u*)(ao + qrow * 1024 + head * 64 + 32 * dt + 8 * rg + 4 * h) = ov; }
        }
    }
}

struct GuList {
    int x, base, stride, n, late;
    __device__ __forceinline__ bool next(int i, pg8::Unit& u) const { if (i >= n) return false; const int U = base + stride * i, grp = U / 88, r = U - grp * 88, pml = grp * 4 + (r & 3);
        u.pm = 16 * x + (late ? 4 : 0) + (pml < 4 ? pml : pml + 4); u.pn = r >> 2; return true; }
    __device__ __forceinline__ void a_ready(const pg8::Unit&) const {}
    __device__ __forceinline__ void done(const pg8::Unit&) const {}
};
struct ListOrder {
    int pm0, pn0, pm1, pn1, n;
    __device__ __forceinline__ bool next(int i, pg8::Unit& u) const { if (i >= n) return false; u.pm = i == 0 ? pm0 : pm1; u.pn = i == 0 ? pn0 : pn1; return true; }
    __device__ __forceinline__ void a_ready(const pg8::Unit&) const {}
    __device__ __forceinline__ void done(const pg8::Unit&) const {}
};
constexpr int N_PHASES = 15;
__global__ void __launch_bounds__(NWAVES * 64, 2) yoco_fwd(Args args) {
    extern __shared__ __attribute__((aligned(16))) unsigned char lds_raw[];
    LAS unsigned char* lds = (LAS unsigned char*)lds_raw;
    const int tid = threadIdx.x, lane = tid & 63, wave = __builtin_amdgcn_readfirstlane(tid >> 6);
    const int G = gridDim.x, bid = blockIdx.x;
    unsigned char* ws = args.ws;
    bf16* hb = (bf16*)(ws + WS_HB); float* ssq = (float*)(ws + WS_SSQ); bf16* act = (bf16*)(ws + WS_ACT);
    const float* lbv = (const float*)(ws + WS_MISC); const float* rope = (const float*)(ws + WS_MISC + 65536);
    const int lo = args.ph_lo, hi = args.ph_hi;
    volatile LAS unsigned* bst = (volatile LAS unsigned*)(lds + 131072 + 64);
    if (tid < 4) bst[tid] = 0u;
    __syncthreads();
    XcdBarrier bar; bar.bar = (unsigned*)(ws + WS_BAR); bar.x = 0; bar.st = bst;
    if (hi - lo > 1) { bar.x = xb_xcc_id(); if (tid == 0) bst[2] = xb_add(&bar.bar[XB_XCNT(bar.x)], 1u); }
    __syncthreads();
    const int xcc = (int)bar.x, xrank = (int)bst[2];
    int xl = 0, vc = bid;
#define IN(k) (lo <= (k) && (k) < hi)
    if (lo < 0) cg::this_grid().sync();
#define SEAM(k) do { if (IN(k) && IN((k) + 1)) { if (xl && (k) != 0 && (k) != 2 && (k) != 4) xcd_local_barrier(bar.bar, bar.x, 32u); else xcd_barrier(bar); if (PROBE_DUP == 3) xcd_barrier(bar); } } while (0)
    typedef pg8::StaticOrder SO;
#define GEMM_PHASE(EPI, Aptr, Bptr, NN, KK, Eobj) do { pg8::Gemm g_{(const pg8::bf16_t*)(Aptr), (const pg8::bf16_t*)(Bptr), M, (NN), (KK)}; SO S_; S_.init(M, (NN), G, vc); \
        pg8::gemm_phase<EPI, SO, true, true>(lds, g_, S_, Eobj); } while (0)

    if (IN(0)) { if (PROBE_DUP == 1) { p0_prologue(args, lds, bid, G, wave, lane); __syncthreads(); } p0_prologue(args, lds, bid, G, wave, lane); } SEAM(0);
    if (lo == 0 && hi == N_PHASES) {
        if (tid == 0) { unsigned ok = (G == 256) ? 1u : 0u;
            for (unsigned j = 0; j < 16; ++j) { const unsigned cnt = xb_ld(&bar.bar[XB_XCNT(j)]); if (cnt != (j < 8u ? 32u : 0u)) ok = 0u; }
            bst[3] = ok; }
        __syncthreads();
        xl = (int)bst[3];
        if (xl) vc = xrank * 8 + xcc;
    }
    if (IN(1)) { pg8::EpiSwiGLU E{act, ssq}; GEMM_PHASE(pg8::EpiSwiGLU, hb, ws + WS_WGU + 0 * SZ_WGU, 2 * FF, D, E); if (PROBE_DUP == 6) { __syncthreads(); GEMM_PHASE(pg8::EpiSwiGLU, hb, ws + WS_WGU + 0 * SZ_WGU, 2 * FF, D, E); } } SEAM(1);
    if (IN(2)) { if (PROBE_DUP == 7) { pg8::EpiResid<false> E0{(bf16*)(ws + WS_R + 176 * MiB), (float*)(ws + WS_R + 240 * MiB), args.out, 0.5f}; GEMM_PHASE(pg8::EpiResid<false>, act, ws + WS_WD + 0 * SZ_WD, D, FF, E0); __syncthreads(); }
                 pg8::EpiResid<false> E{hb, ssq, args.out, 0.5f}; GEMM_PHASE(pg8::EpiResid<false>, act, ws + WS_WD + 0 * SZ_WD, D, FF, E); } SEAM(2);
    if (IN(3)) { pg8::EpiHgrnIn E{(bf16*)(ws + WS_HQ), (float*)(ws + WS_HLOGF), (long)((WS_HV - WS_HQ) / 2), (long)((WS_HG - WS_HQ) / 2), lbv, ssq}; GEMM_PHASE(pg8::EpiHgrnIn, hb, ws + WS_WIN, 4096, D, E); if (PROBE_DUP == 9) { __syncthreads(); GEMM_PHASE(pg8::EpiHgrnIn, hb, ws + WS_WIN, 4096, D, E); } } SEAM(3);
    if (IN(4)) { if (PROBE_DUP == 2) { hgrn_phase(lds, (const bf16*)(ws + WS_HQ), (const float*)(ws + WS_HLOGF), (const bf16*)(ws + WS_HV), (const bf16*)(ws + WS_HG), (bf16*)(ws + WS_KB), args.hgrn_onorm_g, G, bid, tid, wave, lane); __syncthreads(); }
                 hgrn_phase(lds, (const bf16*)(ws + WS_HQ), (const float*)(ws + WS_HLOGF), (const bf16*)(ws + WS_HV), (const bf16*)(ws + WS_HG), (bf16*)(ws + WS_HG), args.hgrn_onorm_g, xl ? BATCH * HG_HEADS : G, xl ? (xrank < 16 ? (2 * xcc + (xrank >> 3)) * 8 + (xrank & 7) : BATCH * HG_HEADS) : bid, tid, wave, lane, bar.bar, bar.x, xl ? 17 : -1);
                 __syncthreads();
                 if (xl) { if (xrank >= 16) {
                         p0_transposes<1>(args, lds, (xrank - 16) * 8 + xcc, 128, wave, lane);
                         xcd_local_barrier(bar.bar, bar.x, 32u);
                         __syncthreads();
                         const int e0 = xrank - 16, e1 = e0 + 16; const int pl0 = e0 >> 2, pl1 = e1 >> 2;
                         ListOrder LS{16 * xcc + (pl0 < 4 ? pl0 : pl0 + 4), e0 & 3, 16 * xcc + (pl1 < 4 ? pl1 : pl1 + 4), e1 & 3, 2};
                         pg8::Gemm g_{(const pg8::bf16_t*)(ws + WS_HG), (const pg8::bf16_t*)(ws + WS_WHO), M, D, D}; pg8::EpiResid<false> E5{hb, ssq, args.out, 1.0f};
                         pg8::gemm_phase<pg8::EpiResid<false>, ListOrder, true, true>(lds, g_, LS, E5); } }
                 else if (G > BATCH * HG_HEADS) { if (bid >= BATCH * HG_HEADS) p0_transposes<1>(args, lds, bid - BATCH * HG_HEADS, G - BATCH * HG_HEADS, wave, lane); } else p0_transposes<1>(args, lds, bid, G, wave, lane); } SEAM(4);
    if (xl) {
        pg8::EpiResid<false> E5{hb, ssq, args.out, 1.0f}; pg8::EpiSwiGLU E6{act, ssq};
        pg8::Gemm g5{(const pg8::bf16_t*)(ws + WS_HG), (const pg8::bf16_t*)(ws + WS_WHO), M, D, D};
        pg8::Gemm g6{(const pg8::bf16_t*)hb, (const pg8::bf16_t*)(ws + WS_WGU + 1 * SZ_WGU), M, 2 * FF, D};
        unsigned* dep = bar.bar + XL_DEP(xcc);
        if (xrank >= 16) {
            const int e0 = xrank - 16, e1 = e0 + 16, pl0 = e0 >> 2, pl1 = e1 >> 2;
            ListOrder LS{16 * xcc + 4 + (pl0 < 4 ? pl0 : pl0 + 4), e0 & 3, 16 * xcc + 4 + (pl1 < 4 ? pl1 : pl1 + 4), e1 & 3, 2};
            pg8::gemm_phase<pg8::EpiResid<false>, ListOrder, true, true>(lds, g5, LS, E5);
            xl_signal(dep);
            xl_wait(dep, 16u, bar.bar);
            GuList S6{xcc, xrank - 16, 16, 10, 1};
            pg8::gemm_phase<pg8::EpiSwiGLU, GuList, true, true>(lds, g6, S6, E6);
        } else {
            GuList S6{xcc, xrank, 16, 11, 0};
            pg8::gemm_phase<pg8::EpiSwiGLU, GuList, true, true>(lds, g6, S6, E6);
            xl_wait(dep, 16u, bar.bar);
            GuList S7{xcc, 160 + xrank, 16, 1, 1};
            pg8::gemm_phase<pg8::EpiSwiGLU, GuList, true, true>(lds, g6, S7, E6);
        }
    } else {
    if (IN(5)) { pg8::EpiResid<false> E{hb, ssq, args.out, 1.0f}; GEMM_PHASE(pg8::EpiResid<false>, ws + WS_HG, ws + WS_WHO, D, D, E); } SEAM(5);
    if (IN(6)) { pg8::EpiSwiGLU E{act, ssq}; GEMM_PHASE(pg8::EpiSwiGLU, hb, ws + WS_WGU + 1 * SZ_WGU, 2 * FF, D, E); }
    }
    SEAM(6);
    if (IN(7)) { pg8::EpiResid<false> E{hb, ssq, args.out, 0.5f}; GEMM_PHASE(pg8::EpiResid<false>, act, ws + WS_WD + 1 * SZ_WD, D, FF, E); } SEAM(7);
    if (IN(8)) { pg8::EpiHead<false> E{(bf16*)(ws + WS_KB), (long)((WS_VB - WS_KB) / 2), args.k_norm_g, rope, ssq, 1.0f}; GEMM_PHASE(pg8::EpiHead<false>, hb, ws + WS_WKV, 256, D, E); if (PROBE_DUP == 8) { __syncthreads(); GEMM_PHASE(pg8::EpiHead<false>, hb, ws + WS_WKV, 256, D, E); }
                 __syncthreads();
                 pg8::EpiSwiGLU E2{act, ssq}; GEMM_PHASE(pg8::EpiSwiGLU, hb, ws + WS_WGU + 2 * SZ_WGU, 2 * FF, D, E2); } SEAM(8);
    if (IN(9)) { pg8::EpiResid<false> E{hb, ssq, args.out, 0.5f}; GEMM_PHASE(pg8::EpiResid<false>, act, ws + WS_WD + 2 * SZ_WD, D, FF, E); } SEAM(9);
    if (IN(10)) { pg8::EpiHead<true> E{(bf16*)(ws + WS_QA), 0l, args.q_norm_g, rope, ssq, 0.125f * 1.4426950408889634f}; GEMM_PHASE(pg8::EpiHead<true>, hb, ws + WS_WQ, D, D, E); } SEAM(10);
    if (IN(11)) { if (PROBE_DUP == 4) { attn_phase(lds, (const bf16*)(ws + WS_QA), (const bf16*)(ws + WS_KB), (const bf16*)(ws + WS_VB), (bf16*)(ws + WS_R + 128 * MiB), args.attn_sinks, G, bid, BATCH * NBLK * ATT_KVH, tid, wave, lane); __syncthreads(); }
                  attn_phase(lds, (const bf16*)(ws + WS_QA), (const bf16*)(ws + WS_KB), (const bf16*)(ws + WS_VB), (bf16*)(ws + WS_QA), args.attn_sinks, xl ? 32 : G, xl ? 64 * xcc + xrank : bid, xl ? 64 * xcc + 64 : BATCH * NBLK * ATT_KVH, tid, wave, lane); } SEAM(11);
    if (IN(12)) { if (PROBE_DUP == 10) { pg8::EpiResid<false> E0{(bf16*)(ws + WS_R + 176 * MiB), (float*)(ws + WS_R + 240 * MiB), args.out, 1.0f}; GEMM_PHASE(pg8::EpiResid<false>, ws + WS_QA, ws + WS_WAO, D, D, E0); __syncthreads(); }
                  pg8::EpiResid<false> E{hb, ssq, args.out, 1.0f}; GEMM_PHASE(pg8::EpiResid<false>, ws + WS_QA, ws + WS_WAO, D, D, E); } SEAM(12);
    if (IN(13)) { pg8::EpiSwiGLU E{act, ssq}; GEMM_PHASE(pg8::EpiSwiGLU, hb, ws + WS_WGU + 3 * SZ_WGU, 2 * FF, D, E); } SEAM(13);
    if (IN(14)) { pg8::EpiResid<true> E{hb, ssq, args.out, 0.5f}; GEMM_PHASE(pg8::EpiResid<true>, act, ws + WS_WD + 3 * SZ_WD, D, FF, E); }
#undef IN
#undef SEAM
#undef GEMM_PHASE
}

extern "C" void kernel_launch(void* const* d_in, const int* in_sizes, int n_in, void* d_out, int out_size, void* d_ws, size_t ws_size, hipStream_t stream) {
    static int grid = 0;
    if (grid == 0) {
        if (n_in != 16 || in_sizes[0] != M * D || out_size != M * D || ws_size < WS_END) { fprintf(stderr, "kernel_launch: unexpected problem (n_in %d, in0 %d, out %d, ws %zu, need %zu)\n", n_in, n_in > 0 ? in_sizes[0] : -1, out_size, ws_size, (size_t)WS_END); grid = -1; return; }
        int dev = 0, cus = 0, per_cu = 0;
        if (hipGetDevice(&dev) != hipSuccess || hipDeviceGetAttribute(&cus, hipDeviceAttributeMultiprocessorCount, dev) != hipSuccess) { grid = -1; return; }
        if (hipFuncSetAttribute((const void*)yoco_fwd, hipFuncAttributeMaxDynamicSharedMemorySize, LDS_BYTES) != hipSuccess) { fprintf(stderr, "kernel_launch: hipFuncSetAttribute failed\n"); grid = -1; return; }
        if (hipOccupancyMaxActiveBlocksPerMultiprocessor(&per_cu, (const void*)yoco_fwd, NWAVES * 64, LDS_BYTES) != hipSuccess || per_cu < 1) { fprintf(stderr, "kernel_launch: occupancy query says %d\n", per_cu); per_cu = 1; }
        (void)hipGetLastError();
        grid = cus;
    }
    if (grid < 0) return;
    Args a{};
    a.x = (const float*)d_in[0]; a.ffn_norm_g = (const float*)d_in[1]; a.ffn_w_gate_up = (const float*)d_in[2]; a.ffn_w_down = (const float*)d_in[3]; a.mix_norm_g = (const float*)d_in[4];
    a.hgrn_w_in = (const float*)d_in[5]; a.hgrn_lb_logits = (const float*)d_in[6]; a.hgrn_onorm_g = (const float*)d_in[7]; a.hgrn_w_out = (const float*)d_in[8]; a.kv_norm_g = (const float*)d_in[9];
    a.kv_w = (const float*)d_in[10]; a.k_norm_g = (const float*)d_in[11]; a.attn_w_q = (const float*)d_in[12]; a.q_norm_g = (const float*)d_in[13]; a.attn_sinks = (const float*)d_in[14]; a.attn_w_out = (const float*)d_in[15];
    a.out = (float*)d_out; a.ws = (unsigned char*)d_ws;
#if MK_ONE_LAUNCH
    if (hipMemsetAsync((char*)d_ws + WS_BAR, 0, BAR_BYTES, stream) != hipSuccess) { fprintf(stderr, "kernel_launch: memset failed\n"); return; }
    a.ph_lo = 0; a.ph_hi = N_PHASES;
    void* kargs[] = {&a};
    hipError_t e = hipLaunchCooperativeKernel((const void*)yoco_fwd, dim3(grid), dim3(NWAVES * 64), kargs, LDS_BYTES, stream);
    if (e != hipSuccess) fprintf(stderr, "kernel_launch: cooperative launch failed: %s (grid %d)\n", hipGetErrorString(e), grid);
#else
    for (int p = 0; p < N_PHASES; ++p) { a.ph_lo = p; a.ph_hi = p + 1; hipLaunchKernelGGL(yoco_fwd, dim3(grid), dim3(NWAVES * 64), LDS_BYTES, stream, a); }
#endif
}
```

```cpp
#include <hip/hip_runtime.h>
#include <hip/hip_cooperative_groups.h>
#include <cstdio>
#include <cstdint>
namespace cg = cooperative_groups;
namespace pg8 {
#define PG8_LAS __attribute__((address_space(3)))
typedef unsigned short bf16_t;
typedef short bf16x8 __attribute__((ext_vector_type(8)));
typedef float f32x4 __attribute__((ext_vector_type(4)));
typedef unsigned u32x4 __attribute__((ext_vector_type(4)));
constexpr int BM = 256, BK = 64, HALF = 128, HTB = HALF * BK * 2  , STAGE_BYTES = 8 * HTB, NXCD = 8, WGM = 4;

__host__ __device__ __forceinline__ int lds_byte(int r, int c) { const int st = (r >> 4) * 2 + (c >> 5), rr = r & 15, cc = c & 31, ob = rr * 64 + cc * 2; return st * 1024 + (ob ^ (((ob >> 9) & 1) << 5)); }
__host__ __device__ __forceinline__ void stage_rc(int b, int& R, int& C) { const int st = b / 1024, sb = b % 1024, swz = sb ^ (((sb >> 9) & 1) << 5); R = (st >> 1) * 16 + swz / 64; C = (st & 1) * 32 + (swz % 64) / 2; }
__host__ __device__ __forceinline__ int perm32(int rho) { const int n = rho >> 4, i = rho & 15; return 8 * (i >> 2) + 4 * n + (i & 3); }

struct Unit { int pm, pn; };
struct Gemm { const bf16_t* A; const bf16_t* Bt; int M, N, K; };

struct StaticOrder {
    int nM, nN, nwg, G, c;
    __host__ __device__ void init(int M, int N, int G_, int c_) { nM = M / BM; nN = N / BM; nwg = nM * nN; G = G_; c = c_; }
    __host__ __device__ bool next(int i, Unit& u) const {
        const long L = (long)i * G + c; if (L >= nwg) return false;
        int wgid = (int)L; { const int q = nwg / NXCD, r = nwg % NXCD, xcd = wgid % NXCD, off = wgid / NXCD; wgid = (xcd < r ? xcd * (q + 1) : r * (q + 1) + (xcd - r) * q) + off; }
        const int nig = WGM * nN, gid = wgid / nig, fm = gid * WGM, gsz = (nM - fm) < WGM ? (nM - fm) : WGM;
        u.pm = fm + ((wgid % nig) % gsz); u.pn = (wgid % nig) / gsz; return true;
    }
    __device__ __forceinline__ void a_ready(const Unit&) const {}
    __device__ __forceinline__ void done(const Unit&) const {}
};

__device__ __forceinline__ unsigned cvt_pk_bf16(float lo, float hi) { unsigned r; asm volatile("v_cvt_pk_bf16_f32 %0, %1, %2" : "=v"(r) : "v"(lo), "v"(hi)); return r; }
typedef float f32x2 __attribute__((ext_vector_type(2)));
#ifndef MK_WT_STORES
#define MK_WT_STORES 0
#endif
__device__ __forceinline__ void st16(void* p, u32x4 v) {
#if MK_WT_STORES
    asm volatile("global_store_dwordx4 %0, %1, off sc1\n\ts_nop 1" :: "v"(p), "v"(v) : "memory");
#else
    *(u32x4*)p = v;
#endif
}
__device__ __forceinline__ float fast_rcp(float x) { return __builtin_amdgcn_rcpf(x); }
__device__ __forceinline__ float silu_f(float x) { return x * fast_rcp(1.0f + __expf(-x)); }
__device__ __forceinline__ float sigmoid_f(float x) { return fast_rcp(1.0f + __expf(-x)); }
__device__ __forceinline__ float row_rstd(const float* ssq, int row) {
    const f32x4* p = (const f32x4*)(ssq + (size_t)row * 16);
    const f32x4 a = p[0], b = p[1], c = p[2], d = p[3];
    const float s = (((a[0] + a[1]) + (a[2] + a[3])) + ((b[0] + b[1]) + (b[2] + b[3]))) + (((c[0] + c[1]) + (c[2] + c[3])) + ((d[0] + d[1]) + (d[2] + d[3])));
    return __builtin_amdgcn_rsqf(s * (1.0f / 1024.0f) + 1e-6f);
}
__device__ __forceinline__ void row_rstd8(const float* ssq, int row0, int fq, float (&rs)[8]) {
    f32x4 pv[8];
#pragma unroll
    for (int r = 0; r < 8; ++r) pv[r] = *(const f32x4*)(ssq + (size_t)(row0 + (r >> 2) * HALF + (r & 3) * 16) * 16 + 4 * fq);
#pragma unroll
    for (int r = 0; r < 8; ++r) { float t = (pv[r][0] + pv[r][1]) + (pv[r][2] + pv[r][3]); t += __shfl_xor(t, 16); t += __shfl_xor(t, 32); rs[r] = __builtin_amdgcn_rsqf(t * (1.0f / 1024.0f) + 1e-6f); }
}
struct EpiSwiGLU {
    static constexpr bool PERM = true, AFTER_DRAIN = false;
    bf16_t* O; const float* ssq;
    __device__ __forceinline__ void operator()(const f32x4 (&acc)[2][2][4][2], const Unit& u, int wr, int wc, int fr, int fq) const {
        typedef float f2 __attribute__((ext_vector_type(2)));
        const int row0 = u.pm * BM + wr * 64 + fr, col0 = u.pn * 128 + wc * 32 + 8 * fq;
        float rsv[8]; row_rstd8(ssq, row0, fq, rsv);
#pragma unroll
        for (int ai = 0; ai < 2; ++ai)
#pragma unroll
            for (int m = 0; m < 4; ++m) {
                const int row = row0 + ai * HALF + m * 16; const float rs = rsv[ai * 4 + m];
                const float nrl = rs * -1.4426950408889634f, rs2 = rs * rs;
                unsigned w4[4];
#pragma unroll
                for (int n = 0; n < 2; ++n)
#pragma unroll
                    for (int e = 0; e < 4; e += 2) {
                        const f2 g = (f2){acc[ai][0][m][n][e], acc[ai][0][m][n][e + 1]}, up = (f2){acc[ai][1][m][n][e], acc[ai][1][m][n][e + 1]};
                        const f2 t = g * nrl; f2 ex; ex.x = __builtin_amdgcn_exp2f(t.x); ex.y = __builtin_amdgcn_exp2f(t.y);
                        const f2 d = ex + 1.0f; f2 r; r.x = __builtin_amdgcn_rcpf(d.x); r.y = __builtin_amdgcn_rcpf(d.y);
                        const f2 o = ((g * up) * rs2) * r;
                        w4[2 * n + (e >> 1)] = cvt_pk_bf16(o.x, o.y);
                    }
                u32x4 w; w.x = w4[0]; w.y = w4[1]; w.z = w4[2]; w.w = w4[3];
                st16(O + (size_t)row * 2816 + col0, w);
            }
    }
};
template <bool FINAL> struct EpiResid {
    static constexpr bool PERM = true, AFTER_DRAIN = false;
    bf16_t* hb; float* ssq; float* out; float scale;
    __device__ __forceinline__ void operator()(const f32x4 (&acc)[2][2][4][2], const Unit& u, int wr, int wc, int fr, int fq) const {
        const int row0 = u.pm * BM + wr * 64 + fr, col0 = u.pn * BM + wc * 32 + 8 * fq;
        u32x4 bs[2][4][2];
#pragma unroll
        for (int ai = 0; ai < 2; ++ai)
#pragma unroll
            for (int m = 0; m < 4; ++m)
#pragma unroll
                for (int bj = 0; bj < 2; ++bj) bs[ai][m][bj] = *(const u32x4*)(hb + (size_t)(row0 + ai * HALF + m * 16) * 1024 + col0 + bj * HALF);
#pragma unroll
        for (int ai = 0; ai < 2; ++ai) {
#pragma unroll
            for (int m = 0; m < 4; ++m) {
                const int row = row0 + ai * HALF + m * 16; const size_t off = (size_t)row * 1024 + col0; float ss = 0.f;
#pragma unroll
                for (int bj = 0; bj < 2; ++bj) {
                    const u32x4 b = bs[ai][m][bj];
                    f32x4 o0, o1;
                    o0[0] = __builtin_bit_cast(float, b.x << 16) + acc[ai][bj][m][0][0] * scale; o0[1] = __builtin_bit_cast(float, b.x & 0xffff0000u) + acc[ai][bj][m][0][1] * scale;
                    o0[2] = __builtin_bit_cast(float, b.y << 16) + acc[ai][bj][m][0][2] * scale; o0[3] = __builtin_bit_cast(float, b.y & 0xffff0000u) + acc[ai][bj][m][0][3] * scale;
                    o1[0] = __builtin_bit_cast(float, b.z << 16) + acc[ai][bj][m][1][0] * scale; o1[1] = __builtin_bit_cast(float, b.z & 0xffff0000u) + acc[ai][bj][m][1][1] * scale;
                    o1[2] = __builtin_bit_cast(float, b.w << 16) + acc[ai][bj][m][1][2] * scale; o1[3] = __builtin_bit_cast(float, b.w & 0xffff0000u) + acc[ai][bj][m][1][3] * scale;
                    if (FINAL) { *(f32x4*)(out + off + bj * HALF) = o0; *(f32x4*)(out + off + bj * HALF + 4) = o1; }
                    else { u32x4 w; w.x = cvt_pk_bf16(o0[0], o0[1]); w.y = cvt_pk_bf16(o0[2], o0[3]); w.z = cvt_pk_bf16(o1[0], o1[1]); w.w = cvt_pk_bf16(o1[2], o1[3]); st16(hb + off + bj * HALF, w);
                        ss += ((o0[0] * o0[0] + o0[1] * o0[1]) + (o0[2] * o0[2] + o0[3] * o0[3])) + ((o1[0] * o1[0] + o1[1] * o1[1]) + (o1[2] * o1[2] + o1[3] * o1[3])); }
                }
                if (!FINAL) { ss += __shfl_xor(ss, 16); ss += __shfl_xor(ss, 32); if (fq == 0) ssq[(size_t)row * 16 + u.pn * 4 + wc] = ss; }
            }
        }
    }
};
struct EpiHgrnIn {
    static constexpr bool PERM = true, AFTER_DRAIN = false;
    bf16_t* qb; float* logf; long off_v; long off_g; const float* lbv; const float* ssq;
    template <int REGION> __device__ __forceinline__ void body(const f32x4 (&acc)[2][2][4][2], const Unit& u, int wr, int wc, int fr, int fq) const {
        typedef float f2 __attribute__((ext_vector_type(2)));
        const int row0 = u.pm * BM + wr * 64 + fr, col0 = (u.pn & 3) * BM + wc * 32 + 8 * fq;
        float rsv[8]; row_rstd8(ssq, row0, fq, rsv);
        f32x4 lb[2][2];
        if (REGION == 1) {
#pragma unroll
            for (int bj = 0; bj < 2; ++bj)
#pragma unroll
                for (int n = 0; n < 2; ++n) lb[bj][n] = *(const f32x4*)(lbv + col0 + bj * HALF + 4 * n);
        }
        bf16_t* dst = REGION == 0 ? qb : (REGION == 1 ? (bf16_t*)logf : (REGION == 2 ? qb + off_v : qb + off_g));
#pragma unroll
        for (int ai = 0; ai < 2; ++ai)
#pragma unroll
            for (int m = 0; m < 4; ++m) {
                const int row = row0 + ai * HALF + m * 16; const float rs = rsv[ai * 4 + m]; const size_t off = (size_t)row * 1024 + col0;
                const float nrl = rs * -1.4426950408889634f;
#pragma unroll
                for (int bj = 0; bj < 2; ++bj) {
                    f32x4 vv[2];
#pragma unroll
                    for (int n = 0; n < 2; ++n)
#pragma unroll
                        for (int e = 0; e < 4; e += 2) {
                            const f2 a = (f2){acc[ai][bj][m][n][e], acc[ai][bj][m][n][e + 1]};
                            f2 o;
                            if (REGION == 2) o = a * rs;
                            else {
                                const f2 t = a * nrl; f2 ex; ex.x = __builtin_amdgcn_exp2f(t.x); ex.y = __builtin_amdgcn_exp2f(t.y);
                                const f2 d = ex + 1.0f; f2 sg; sg.x = __builtin_amdgcn_rcpf(d.x); sg.y = __builtin_amdgcn_rcpf(d.y);
                                if (REGION == 1) { const f2 l = (f2){lb[bj][n][e], lb[bj][n][e + 1]}; o = l + (1.0f - l) * sg; }
                                else o = (a * rs) * sg;
                            }
                            vv[n][e] = o.x; vv[n][e + 1] = o.y;
                        }
                    u32x4 w;
                    if (REGION == 1) {
                        typedef _Float16 h2v __attribute__((ext_vector_type(2)));
                        w.x = __builtin_bit_cast(unsigned, __builtin_convertvector((f2){vv[0][0], vv[0][1]}, h2v)); w.y = __builtin_bit_cast(unsigned, __builtin_convertvector((f2){vv[0][2], vv[0][3]}, h2v));
                        w.z = __builtin_bit_cast(unsigned, __builtin_convertvector((f2){vv[1][0], vv[1][1]}, h2v)); w.w = __builtin_bit_cast(unsigned, __builtin_convertvector((f2){vv[1][2], vv[1][3]}, h2v));
                    } else { w.x = cvt_pk_bf16(vv[0][0], vv[0][1]); w.y = cvt_pk_bf16(vv[0][2], vv[0][3]); w.z = cvt_pk_bf16(vv[1][0], vv[1][1]); w.w = cvt_pk_bf16(vv[1][2], vv[1][3]); }
                    st16(dst + off + bj * HALF, w);
                }
            }
    }
    __device__ __forceinline__ void operator()(const f32x4 (&acc)[2][2][4][2], const Unit& u, int wr, int wc, int fr, int fq) const {
        const int region = u.pn >> 2;
        if (region == 0) body<0>(acc, u, wr, wc, fr, fq); else if (region == 1) body<1>(acc, u, wr, wc, fr, fq); else if (region == 2) body<2>(acc, u, wr, wc, fr, fq); else body<3>(acc, u, wr, wc, fr, fq);
    }
};
template <bool IS_Q> struct EpiHead {
    static constexpr bool PERM = true, AFTER_DRAIN = false;
    bf16_t* O; long off2; const float* gain; const float* rope; const float* ssq; float oscale;
    __device__ __forceinline__ void operator()(const f32x4 (&acc)[2][2][4][2], const Unit& u, int wr, int wc, int fr, int fq) const {
        const int row0 = u.pm * BM + wr * 64 + fr;
        const bool normed = IS_Q || wc < 2;
        float rsv[8]; row_rstd8(ssq, row0, fq, rsv);
        f32x4 gn[2][2];
#pragma unroll
        for (int bj = 0; bj < 2; ++bj)
#pragma unroll
            for (int n = 0; n < 2; ++n) gn[bj][n] = *(const f32x4*)(gain + bj * 32 + 8 * fq + 4 * n);
        bf16_t* dst; int ldo, cbase;
        if (IS_Q) { dst = O; ldo = 1024; cbase = (u.pn * 4 + wc) * 64; } else { dst = O + (wc < 2 ? 0l : off2); ldo = 128; cbase = (wc & 1) * 64; }
#pragma unroll
        for (int ai = 0; ai < 2; ++ai)
#pragma unroll
            for (int m = 0; m < 4; ++m) {
                const int row = row0 + ai * HALF + m * 16; const float rs = rsv[ai * 4 + m];
                f32x4 v[2][2]; float ss = 0.f;
#pragma unroll
                for (int bj = 0; bj < 2; ++bj)
#pragma unroll
                    for (int n = 0; n < 2; ++n) { v[bj][n] = acc[ai][bj][m][n] * rs; ss += (v[bj][n][0] * v[bj][n][0] + v[bj][n][1] * v[bj][n][1]) + (v[bj][n][2] * v[bj][n][2] + v[bj][n][3] * v[bj][n][3]); }
                ss += __shfl_xor(ss, 16); ss += __shfl_xor(ss, 32);
                if (normed) {
                    const float r = __builtin_amdgcn_rsqf(ss * (1.0f / 64.0f) + 1e-6f);
#pragma unroll
                    for (int bj = 0; bj < 2; ++bj)
#pragma unroll
                        for (int n = 0; n < 2; ++n) v[bj][n] = v[bj][n] * r * gn[bj][n];
                }
                f32x4 p0, p1;
#pragma unroll
                for (int e = 0; e < 4; ++e) { p0[e] = __shfl_xor(v[0][0][e], 16); p1[e] = __shfl_xor(v[0][1][e], 16); }
                if (normed && fq < 2) {
                    const f32x4* cs = (const f32x4*)(rope + (size_t)(row & 2047) * 16);
                    const f32x4 c0 = cs[0], c1 = cs[1], c2 = cs[2], c3 = cs[3];
                    const float sg = fq == 0 ? -1.0f : 1.0f;
                    v[0][0][0] = v[0][0][0] * c0[0] + sg * p0[0] * c0[1]; v[0][0][1] = v[0][0][1] * c0[2] + sg * p0[1] * c0[3];
                    v[0][0][2] = v[0][0][2] * c1[0] + sg * p0[2] * c1[1]; v[0][0][3] = v[0][0][3] * c1[2] + sg * p0[3] * c1[3];
                    v[0][1][0] = v[0][1][0] * c2[0] + sg * p1[0] * c2[1]; v[0][1][1] = v[0][1][1] * c2[2] + sg * p1[1] * c2[3];
                    v[0][1][2] = v[0][1][2] * c3[0] + sg * p1[2] * c3[1]; v[0][1][3] = v[0][1][3] * c3[2] + sg * p1[3] * c3[3];
                }
                if (!IS_Q && wc >= 2) {
                    const int bb = row >> 11, blk = (row >> 7) & 15, sl = row & 127;
                    bf16_t* vt = O + off2 + ((((size_t)bb * 16 + blk) * 2 + (wc & 1)) * 64) * 128 + sl;
#pragma unroll
                    for (int bj = 0; bj < 2; ++bj)
#pragma unroll
                        for (int n = 0; n < 2; ++n)
#pragma unroll
                            for (int e = 0; e < 4; e += 2) { const unsigned pk = cvt_pk_bf16(v[bj][n][e], v[bj][n][e + 1]); const int d = bj * 32 + 8 * fq + 4 * n + e;
                                vt[(size_t)d * 128] = (bf16_t)(pk & 0xffffu); vt[(size_t)(d + 1) * 128] = (bf16_t)(pk >> 16); }
                } else {
#pragma unroll
                for (int bj = 0; bj < 2; ++bj) {
                    const f32x4 a = v[bj][0] * oscale, b = v[bj][1] * oscale;
                    u32x4 w; w.x = cvt_pk_bf16(a[0], a[1]); w.y = cvt_pk_bf16(a[2], a[3]); w.z = cvt_pk_bf16(b[0], b[1]); w.w = cvt_pk_bf16(b[2], b[3]);
                    st16(dst + (size_t)row * ldo + cbase + bj * 32 + 8 * fq, w);
                }
                }
            }
    }
};

template <class Epi, class Sched, bool ALIGN_EPI = false, bool SP2 = false>
__device__ __forceinline__ void gemm_phase(PG8_LAS unsigned char* lds, const Gemm g, const Sched& S, const Epi& E) {
    const int tid = threadIdx.x, wid = __builtin_amdgcn_readfirstlane(tid >> 6), lane = tid & 63, wr = wid >> 2, wc = wid & 3, fr = lane & 15, fq = lane >> 4;
    const int K = g.K, nt = K / BK;
    unsigned voffA[2], voffB[2];
#pragma unroll
    for (int i = 0; i < 2; ++i) { int R, C; stage_rc(tid * 16 + i * 8192, R, C); const int Rb = Epi::PERM ? ((R & ~31) + perm32(R & 31)) : R;
        voffA[i] = (unsigned)(R * K + C) * 2u; voffB[i] = (unsigned)(Rb * K + C) * 2u; }
    const size_t kstep = (size_t)(BK * 2);
    const size_t hstep = (size_t)HALF * K * 2;
    const size_t tstep = 2 * hstep;
    const unsigned ldsw = (unsigned)wid * 1024u;
    const int aoff = lds_byte(wr * 64 + fr, fq * 8), boff = lds_byte(wc * 32 + fr, fq * 8);
#define PG8_SA(b, h) (((b) * 2 + (h)) * HTB)
#define PG8_SB(b, h) ((4 + (b) * 2 + (h)) * HTB)
#define PG8_STAGE(bufoff, gbase, voff) do { _Pragma("unroll") for (int _i = 0; _i < 2; ++_i) \
        __builtin_amdgcn_global_load_lds((const unsigned*)((const char*)(gbase) + (voff)[_i]), (PG8_LAS unsigned*)(lds + (bufoff) + ldsw + _i * 8192), 16, 0, 0); } while (0)
#define PG8_LDA(dst, b, h) do { _Pragma("unroll") for (int m = 0; m < 4; ++m) _Pragma("unroll") for (int k = 0; k < 2; ++k) dst[m][k] = *(const PG8_LAS bf16x8*)(lds + PG8_SA(b, h) + aoff + m * 2048 + k * 1024); } while (0)
#define PG8_LDB(dst, b, h) do { _Pragma("unroll") for (int n = 0; n < 2; ++n) _Pragma("unroll") for (int k = 0; k < 2; ++k) dst[n][k] = *(const PG8_LAS bf16x8*)(lds + PG8_SB(b, h) + boff + n * 2048 + k * 1024); } while (0)
#define PG8_MMA(ai, bj, At, Bt) do { __builtin_amdgcn_s_setprio(1); _Pragma("unroll") for (int m = 0; m < 4; ++m) _Pragma("unroll") for (int n = 0; n < 2; ++n) _Pragma("unroll") for (int k = 0; k < 2; ++k) \
        acc[ai][bj][m][n] = __builtin_amdgcn_mfma_f32_16x16x32_bf16(Bt[n][k], At[m][k], acc[ai][bj][m][n], 0, 0, 0); __builtin_amdgcn_s_setprio(0); } while (0)
#define PG8_WAIT_V(n) asm volatile("s_waitcnt vmcnt(" #n ")" ::: "memory")
#define PG8_WAIT_L(n) asm volatile("s_waitcnt lgkmcnt(" #n ")" ::: "memory")
#define PG8_BAR __builtin_amdgcn_s_barrier()
#define PG8_SCHED __builtin_amdgcn_sched_barrier(0)
    Unit cur, nxt; int ui = 0;
    if (!S.next(0, cur)) return;
    f32x4 acc[2][2][4][2];
#pragma unroll
    for (int a = 0; a < 2; ++a)
#pragma unroll
        for (int b = 0; b < 2; ++b)
#pragma unroll
            for (int m = 0; m < 4; ++m)
#pragma unroll
                for (int n = 0; n < 2; ++n) acc[a][b][m][n] = (f32x4){0.f, 0.f, 0.f, 0.f};
    bf16x8 At[4][2], B0[2][2], B1[2][2];
    const char* cA = (const char*)g.A + (size_t)cur.pm * tstep; const char* cB = (const char*)g.Bt + (size_t)cur.pn * tstep;
    S.a_ready(cur);
    if constexpr (SP2) {
        PG8_STAGE(PG8_SB(0, 0), cB, voffB); PG8_STAGE(PG8_SB(0, 1), cB + hstep, voffB); PG8_STAGE(PG8_SA(0, 0), cA, voffA); PG8_STAGE(PG8_SA(0, 1), cA + hstep, voffA);
        if (wr == 1) PG8_BAR;
        PG8_WAIT_V(2); PG8_BAR;
        PG8_STAGE(PG8_SB(1, 0), cB + kstep, voffB); PG8_STAGE(PG8_SA(1, 0), cA + kstep, voffA); PG8_STAGE(PG8_SB(1, 1), cB + hstep + kstep, voffB);
        PG8_WAIT_V(6); PG8_BAR;
    } else {
        PG8_STAGE(PG8_SB(0, 0), cB, voffB); PG8_STAGE(PG8_SA(0, 0), cA, voffA); PG8_STAGE(PG8_SB(0, 1), cB + hstep, voffB); PG8_STAGE(PG8_SA(0, 1), cA + hstep, voffA);
        if (wr == 1) PG8_BAR;
        PG8_WAIT_V(4); PG8_BAR;
        PG8_STAGE(PG8_SB(1, 0), cB + kstep, voffB); PG8_STAGE(PG8_SA(1, 0), cA + kstep, voffA); PG8_STAGE(PG8_SB(1, 1), cB + hstep + kstep, voffB);
        PG8_WAIT_V(6); PG8_BAR;
    }
    for (;;) {
        const bool has_next = S.next(ui + 1, nxt);
        const char* nA = has_next ? (const char*)g.A + (size_t)nxt.pm * tstep : cA; const char* nB = has_next ? (const char*)g.Bt + (size_t)nxt.pn * tstep : cB;
        for (int t = 0; t < nt; t += 2) {
            const bool last = (t == nt - 2);
            const char* a1 = cA + (size_t)(t + 1) * kstep;
            const char* a2 = last ? nA : cA + (size_t)(t + 2) * kstep; const char* b2 = last ? nB : cB + (size_t)(t + 2) * kstep;
            const char* a3 = a2 + kstep; const char* b3 = b2 + kstep;
            if (last && has_next) S.a_ready(nxt);
            if constexpr (SP2) {
            PG8_LDB(B0, 0, 0); PG8_LDB(B1, 0, 1); PG8_SCHED; PG8_LDA(At, 0, 0); PG8_STAGE(PG8_SA(1, 1), a1 + hstep, voffA);
            PG8_WAIT_V(8); PG8_WAIT_L(0); PG8_BAR; PG8_MMA(0, 0, At, B0); PG8_MMA(0, 1, At, B1); PG8_BAR; PG8_SCHED;
            PG8_LDA(At, 0, 1); PG8_STAGE(PG8_SB(0, 0), b2, voffB); PG8_STAGE(PG8_SB(0, 1), b2 + hstep, voffB); PG8_STAGE(PG8_SA(0, 0), a2, voffA);
            PG8_WAIT_V(8); PG8_WAIT_L(0); PG8_BAR; PG8_MMA(1, 0, At, B0); PG8_MMA(1, 1, At, B1); PG8_BAR; PG8_SCHED;
            PG8_LDB(B0, 1, 0); PG8_LDB(B1, 1, 1); PG8_SCHED; PG8_LDA(At, 1, 0); PG8_STAGE(PG8_SA(0, 1), a2 + hstep, voffA);
            PG8_WAIT_V(8); PG8_WAIT_L(0); PG8_BAR; PG8_MMA(0, 0, At, B0); PG8_MMA(0, 1, At, B1); PG8_BAR; PG8_SCHED;
            PG8_LDA(At, 1, 1); PG8_STAGE(PG8_SB(1, 0), b3, voffB); PG8_STAGE(PG8_SB(1, 1), b3 + hstep, voffB); PG8_STAGE(PG8_SA(1, 0), a3, voffA);
            PG8_WAIT_V(8); PG8_WAIT_L(0); PG8_BAR; PG8_MMA(1, 0, At, B0); PG8_MMA(1, 1, At, B1); PG8_BAR; PG8_SCHED;
            } else {
            PG8_LDB(B0, 0, 0); PG8_SCHED; PG8_LDA(At, 0, 0); PG8_STAGE(PG8_SA(1, 1), a1 + hstep, voffA);
            PG8_WAIT_L(8); PG8_BAR; PG8_WAIT_L(0); PG8_MMA(0, 0, At, B0); PG8_BAR; PG8_SCHED;
            PG8_LDB(B1, 0, 1); PG8_STAGE(PG8_SB(0, 0), b2, voffB);
            PG8_BAR; PG8_WAIT_L(0); PG8_MMA(0, 1, At, B1); PG8_BAR;
            PG8_LDA(At, 0, 1); PG8_STAGE(PG8_SA(0, 0), a2, voffA);
            PG8_BAR; PG8_WAIT_L(0); PG8_MMA(1, 0, At, B0); PG8_BAR; PG8_SCHED;
            PG8_STAGE(PG8_SB(0, 1), b2 + hstep, voffB);
            PG8_WAIT_V(6); PG8_BAR; PG8_MMA(1, 1, At, B1); PG8_BAR;
            PG8_LDB(B0, 1, 0); PG8_SCHED; PG8_LDA(At, 1, 0); PG8_STAGE(PG8_SA(0, 1), a2 + hstep, voffA);
            PG8_WAIT_L(8); PG8_BAR; PG8_WAIT_L(0); PG8_MMA(0, 0, At, B0); PG8_BAR; PG8_SCHED;
            PG8_LDB(B1, 1, 1); PG8_STAGE(PG8_SB(1, 0), b3, voffB);
            PG8_BAR; PG8_WAIT_L(0); PG8_MMA(0, 1, At, B1); PG8_BAR;
            PG8_LDA(At, 1, 1); PG8_STAGE(PG8_SA(1, 0), a3, voffA);
            PG8_BAR; PG8_WAIT_L(0); PG8_MMA(1, 0, At, B0); PG8_BAR; PG8_SCHED;
            PG8_STAGE(PG8_SB(1, 1), b3 + hstep, voffB);
            PG8_WAIT_V(6); PG8_BAR; PG8_MMA(1, 1, At, B1); PG8_BAR;
            }
        }
        if constexpr (ALIGN_EPI) { if (wr == 0) PG8_BAR; }
        if constexpr (!Epi::AFTER_DRAIN) { E(acc, cur, wr, wc, fr, fq); S.done(cur); }
        if (!has_next) break;
#pragma unroll
        for (int a = 0; a < 2; ++a)
#pragma unroll
            for (int b = 0; b < 2; ++b)
#pragma unroll
                for (int m = 0; m < 4; ++m)
#pragma unroll
                    for (int n = 0; n < 2; ++n) acc[a][b][m][n] = (f32x4){0.f, 0.f, 0.f, 0.f};
        cur = nxt; cA = nA; cB = nB; ++ui;
        if constexpr (ALIGN_EPI) { if (wr == 1) PG8_BAR; }
    }
    PG8_WAIT_V(0);
    if constexpr (!ALIGN_EPI) { if (wr == 0) PG8_BAR; }
    PG8_BAR;
    if constexpr (Epi::AFTER_DRAIN) { E.fused(acc, cur, wr, wc, fr, fq, lds, wid, lane); S.done(cur); }
#undef PG8_SA
#undef PG8_SB
#undef PG8_STAGE
#undef PG8_LDA
#undef PG8_LDB
#undef PG8_MMA
#undef PG8_WAIT_V
#undef PG8_WAIT_L
#undef PG8_BAR
#undef PG8_SCHED
}
}
#define LAS __attribute__((address_space(3)))
#define XB_TMO      128
#define XB_XCNT(j)  (256  + 64 * (j))
#define XB_XSUB(j)  (1280 + 64 * (j))
#define XB_XGEN(j)  (2304 + 64 * (j))
#define XB_TOP      3328
#define XB_TOPGEN   3392
#define XCD_BAR_WORDS 3456
#define XB_SPIN_CAP (1u << 18)

__device__ __forceinline__ unsigned xb_ld(unsigned* p)              { return __hip_atomic_load(p, __ATOMIC_RELAXED, __HIP_MEMORY_SCOPE_AGENT); }
__device__ __forceinline__ unsigned xb_add(unsigned* p, unsigned v) { return __hip_atomic_fetch_add(p, v, __ATOMIC_RELAXED, __HIP_MEMORY_SCOPE_AGENT); }
__device__ __forceinline__ unsigned xb_xcc_id() { return (unsigned)__builtin_amdgcn_s_getreg((3 << 11) | 20) & 0xFu; }
#define XB_SPIN(cond, bar) do { unsigned _sp = 0; while (cond) { __builtin_amdgcn_s_sleep(1); \
    if ((++_sp & 255u) == 0u) { if (xb_ld(&(bar)[XB_TMO])) break; if (_sp > XB_SPIN_CAP) { atomicAdd(&(bar)[XB_TMO], 1u); break; } } } } while (0)

struct XcdBarrier {
    unsigned* bar; unsigned x;
    volatile LAS unsigned* st;
};

__device__ __forceinline__ XcdBarrier xcd_barrier_post(unsigned* bar, volatile LAS unsigned* st) {
    XcdBarrier b; b.bar = bar; b.x = xb_xcc_id(); b.st = st;
    if (threadIdx.x == 0) (void)xb_add(&bar[XB_XCNT(b.x)], 1u);
    return b;
}
__device__ __forceinline__ void xcd_barrier_complete(unsigned* bar, unsigned x, unsigned& nloc, unsigned& nx) {
    const unsigned G = gridDim.x * gridDim.y * gridDim.z;
    unsigned sum, cnt, mine, sp = 0u;
    for (;;) {
        sum = 0u; cnt = 0u; mine = 0u;
#pragma unroll
        for (unsigned j = 0; j < 16; ++j) { const unsigned c = xb_ld(&bar[XB_XCNT(j)]); sum += c; cnt += (c > 0u) ? 1u : 0u; mine = (j == x) ? c : mine; }
        if (sum == G) break;
        __builtin_amdgcn_s_sleep(1);
        if ((++sp & 255u) == 0u) { if (xb_ld(&bar[XB_TMO])) break; if (sp > XB_SPIN_CAP) { atomicAdd(&bar[XB_TMO], 1u); break; } }
    }
    nloc = mine > 0u ? mine : 1u; nx = cnt > 0u ? cnt : 1u;
}

__device__ __forceinline__ void xcd_barrier(const XcdBarrier& b) {
    asm volatile("s_waitcnt vmcnt(0)" ::: "memory");
    __syncthreads();
    if (threadIdx.x == 0) {
        unsigned* bar = b.bar;
        __builtin_amdgcn_s_waitcnt(0);
        unsigned nloc = b.st[0], nx = b.st[1];
        if (nloc == 0u) { xcd_barrier_complete(bar, b.x, nloc, nx); b.st[0] = nloc; b.st[1] = nx; }
        const unsigned old = xb_add(&bar[XB_XSUB(b.x)], 1u);
        const unsigned gen = old / nloc;
        if (old + 1u == (gen + 1u) * nloc) {
            __builtin_amdgcn_fence(__ATOMIC_RELEASE, "agent");
            asm volatile("s_waitcnt vmcnt(0)" ::: "memory");
            const unsigned og = xb_add(&bar[XB_TOP], 1u);
            const unsigned tg = og / nx;
            if (og + 1u == (tg + 1u) * nx) xb_add(&bar[XB_TOPGEN], 1u);
            else XB_SPIN(xb_ld(&bar[XB_TOPGEN]) == tg, bar);
            __builtin_amdgcn_fence(__ATOMIC_ACQUIRE, "agent");
            xb_add(&bar[XB_XGEN(b.x)], 1u);
            asm volatile("s_waitcnt vmcnt(0)" ::: "memory");
        } else {
            XB_SPIN(xb_ld(&bar[XB_XGEN(b.x)]) == gen, bar);
            __builtin_amdgcn_fence(__ATOMIC_ACQUIRE, "agent");
            asm volatile("s_waitcnt vmcnt(0)" ::: "memory");
        }
    }
    __syncthreads();
}

#define XL_CNT(j)  (3584 + 64 * (j))
#define XL_DEP(j)  (3584 + 64 * (j) + 32)
__device__ __forceinline__ void xcd_local_barrier(unsigned* bar, unsigned x, unsigned nloc) {
    asm volatile("s_waitcnt vmcnt(0)" ::: "memory");
    __syncthreads();
    if (threadIdx.x == 0) {
        __builtin_amdgcn_s_waitcnt(0);
        const unsigned old = xb_add(&bar[XL_CNT(x)], 1u);
        const unsigned target = (old / nloc + 1u) * nloc;
        XB_SPIN(xb_ld(&bar[XL_CNT(x)]) < target, bar);
        __builtin_amdgcn_fence(__ATOMIC_ACQUIRE, "agent");
        asm volatile("s_waitcnt vmcnt(0)" ::: "memory");
    }
    __syncthreads();
}

__device__ __forceinline__ void xl_signal(unsigned* word) {
    asm volatile("s_waitcnt vmcnt(0)" ::: "memory");
    __syncthreads();
    if (threadIdx.x == 0) { __builtin_amdgcn_s_waitcnt(0); (void)xb_add(word, 1u); }
}
__device__ __forceinline__ void xl_wait(unsigned* word, unsigned want, unsigned* bar) {
    __syncthreads();
    if (threadIdx.x == 0) { XB_SPIN(xb_ld(word) < want, bar); __builtin_amdgcn_fence(__ATOMIC_ACQUIRE, "agent"); asm volatile("s_waitcnt vmcnt(0)" ::: "memory"); }
    __syncthreads();
}

constexpr int NWAVES = 8;
constexpr int BATCH = 16, SEQ = 2048, D = 1024, FF = 2816, M = BATCH * SEQ;
constexpr int HG_HEADS = 8, HG_DK = 128, HG_CHUNK = 64, NCHUNK = SEQ / HG_CHUNK;
constexpr int ATT_HEADS = 16, ATT_KVH = 2, ATT_HD = 64, WINDOW = 128, NBLK = SEQ / WINDOW;
constexpr float EPS = 1e-6f;

#ifndef PROBE_DUP
#define PROBE_DUP 0
#endif
#ifndef MK_ONE_LAUNCH
#define MK_ONE_LAUNCH 1
#endif

constexpr size_t MiB = 1u << 20;
constexpr size_t SZ_WGU = (size_t)2 * FF * D * 2, SZ_WD = (size_t)D * FF * 2;
constexpr size_t WS_MISC = 0;
constexpr size_t WS_BAR = 512 * 1024, BAR_BYTES = 16384;
constexpr size_t WS_WGU = 1 * MiB;
constexpr size_t WS_WD = WS_WGU + 4 * SZ_WGU;
constexpr size_t WS_WIN = WS_WD + 4 * SZ_WD;
constexpr size_t WS_WHO = WS_WIN + (size_t)4096 * D * 2;
constexpr size_t WS_WKV = WS_WHO + (size_t)D * D * 2;
constexpr size_t WS_WQ = WS_WKV + (size_t)256 * D * 2;
constexpr size_t WS_WAO = WS_WQ + (size_t)D * D * 2;
constexpr size_t WS_WEND = WS_WAO + (size_t)D * D * 2;
constexpr size_t WS_HB = 88 * MiB;
constexpr size_t WS_SSQ = WS_HB + 64 * MiB;
constexpr size_t WS_KB = WS_SSQ + 2 * MiB;
constexpr size_t WS_VB = WS_KB + 8 * MiB;
constexpr size_t WS_R = WS_VB + 8 * MiB;
constexpr size_t WS_ACT = WS_R;
constexpr size_t WS_HQ = WS_R, WS_HLOGF = WS_R + 64 * MiB, WS_HV = WS_R + 192 * MiB, WS_HG = WS_R + 256 * MiB;
constexpr size_t WS_QA = WS_R + 192 * MiB;
constexpr size_t WS_END = WS_R + 320 * MiB;
static_assert(WS_WEND <= WS_HB && (size_t)M * FF * 2 <= 320 * MiB && WS_END <= 512 * MiB, "d_ws map");

constexpr int LDS_BYTES = 147456;

typedef unsigned short bf16;
typedef unsigned v4u __attribute__((ext_vector_type(4)));
typedef unsigned v2u __attribute__((ext_vector_type(2)));
typedef float f32x4 __attribute__((ext_vector_type(4)));
typedef float f32x16 __attribute__((ext_vector_type(16)));
typedef short bf16x8 __attribute__((ext_vector_type(8)));
#define LDS_WAIT() asm volatile("s_waitcnt lgkmcnt(0)" ::: "memory")
__device__ __forceinline__ unsigned f2bf(float f) { unsigned u = __builtin_bit_cast(unsigned, f); return (u + 0x7fffu + ((u >> 16) & 1u)) >> 16; }
__device__ __forceinline__ unsigned pk2(float lo, float hi) { return pg8::cvt_pk_bf16(lo, hi); }
__device__ __forceinline__ float bf2f(unsigned short b) { return __builtin_bit_cast(float, (unsigned)b << 16); }
__device__ __forceinline__ float wave_sum(float v) {
#pragma unroll
    for (int o = 1; o < 64; o <<= 1) v += __shfl_xor(v, o);
    return v;
}

template <int MODE> __device__ __forceinline__ int remap_row(int n) {
    if (MODE == 1) { const int bj = n >= FF ? 1 : 0, r = n - bj * FF, t = r >> 7, j = r & 127; return 256 * t + 128 * bj + j; }
    if (MODE == 2) { const int head = n >> 6, d = n & 63, pn = head >> 2, wc = head & 3, bj = d >> 5, j = d & 31; return 256 * pn + 128 * bj + 32 * wc + j; }
    return n;
}
struct Args {
    const float* x; const float* ffn_norm_g; const float* ffn_w_gate_up; const float* ffn_w_down; const float* mix_norm_g; const float* hgrn_w_in; const float* hgrn_lb_logits;
    const float* hgrn_onorm_g; const float* hgrn_w_out; const float* kv_norm_g; const float* kv_w; const float* k_norm_g; const float* attn_w_q; const float* q_norm_g;
    const float* attn_sinks; const float* attn_w_out;
    float* out; unsigned char* ws; int ph_lo, ph_hi;
};

struct TItem { const float* W; const float* gk; bf16* WT; int K, N, mode, k0, n0; };
__device__ __forceinline__ int remap_rt(int mode, int n) { return mode == 1 ? remap_row<1>(n) : (mode == 2 ? remap_row<2>(n) : n); }
template <int SET> __device__ __forceinline__ TItem titem(const Args& a, int it) {
    unsigned char* ws = a.ws; TItem t; int r = it;
    constexpr int I_GU = (D / 64) * (2 * FF / 32), I_D = (FF / 64) * (D / 32), I_IN = (D / 64) * (4096 / 32), I_SQ = (D / 64) * (D / 32), I_KV = (D / 64) * (256 / 32);
    if (SET == 0) {
        if (r < I_GU) { t.W = a.ffn_w_gate_up; t.gk = a.ffn_norm_g; t.WT = (bf16*)(ws + WS_WGU); t.K = D; t.N = 2 * FF; t.mode = 1; }
        else if ((r -= I_GU) < I_D) { t.W = a.ffn_w_down; t.gk = nullptr; t.WT = (bf16*)(ws + WS_WD); t.K = FF; t.N = D; t.mode = 0; }
        else if ((r -= I_D) < I_IN) { t.W = a.hgrn_w_in; t.gk = a.mix_norm_g; t.WT = (bf16*)(ws + WS_WIN); t.K = D; t.N = 4096; t.mode = 0; }
        else { r -= I_IN; t.W = a.hgrn_w_out; t.gk = nullptr; t.WT = (bf16*)(ws + WS_WHO); t.K = D; t.N = D; t.mode = 0; }
    } else {
        if (r < 3 * I_GU) { const int l = 1 + r / I_GU; r -= (l - 1) * I_GU; t.W = a.ffn_w_gate_up + (size_t)l * D * 2 * FF; t.gk = a.ffn_norm_g + l * D; t.WT = (bf16*)(ws + WS_WGU + l * SZ_WGU); t.K = D; t.N = 2 * FF; t.mode = 1; }
        else if ((r -= 3 * I_GU) < 3 * I_D) { const int l = 1 + r / I_D; r -= (l - 1) * I_D; t.W = a.ffn_w_down + (size_t)l * FF * D; t.gk = nullptr; t.WT = (bf16*)(ws + WS_WD + l * SZ_WD); t.K = FF; t.N = D; t.mode = 0; }
        else if ((r -= 3 * I_D) < I_KV) { t.W = a.kv_w; t.gk = a.kv_norm_g; t.WT = (bf16*)(ws + WS_WKV); t.K = D; t.N = 256; t.mode = 2; }
        else if ((r -= I_KV) < I_SQ) { t.W = a.attn_w_q; t.gk = a.mix_norm_g + D; t.WT = (bf16*)(ws + WS_WQ); t.K = D; t.N = D; t.mode = 2; }
        else { r -= I_SQ; t.W = a.attn_w_out; t.gk = nullptr; t.WT = (bf16*)(ws + WS_WAO); t.K = D; t.N = D; t.mode = 0; }
    }
    const int nblk = t.N / 32, kb = r / nblk, nb = r - kb * nblk; t.k0 = 64 * kb; t.n0 = 32 * nb;
    return t;
}
struct TRegs { float r[32]; f32x4 g0, g1; };
__device__ __forceinline__ void tload(const TItem& t, int lane, TRegs& q) {
    const float* p = t.W + (size_t)(t.k0 + (lane >> 5)) * t.N + t.n0 + (lane & 31);
#pragma unroll
    for (int i = 0; i < 32; ++i) q.r[i] = p[(size_t)(2 * i) * t.N];
    if (t.gk) { q.g0 = *(const f32x4*)(t.gk + t.k0 + 8 * (lane & 7)); q.g1 = *(const f32x4*)(t.gk + t.k0 + 8 * (lane & 7) + 4); }
    else { q.g0 = (f32x4){1.f, 1.f, 1.f, 1.f}; q.g1 = q.g0; }
}
__device__ __forceinline__ void tfinish(const TItem& t, LAS float* scr, int lane, const TRegs& q) {
#pragma unroll
    for (int i = 0; i < 32; ++i) scr[(2 * i + (lane >> 5)) * 33 + (lane & 31)] = q.r[i];
    LDS_WAIT(); asm volatile("" ::: "memory");
    const int c = lane & 7;
#pragma unroll
    for (int j = 0; j < 4; ++j) { const int n = (lane >> 3) + 8 * j; const LAS float* s = scr + (8 * c) * 33 + n;
        v4u o; o.x = pk2(s[0 * 33] * q.g0[0], s[1 * 33] * q.g0[1]); o.y = pk2(s[2 * 33] * q.g0[2], s[3 * 33] * q.g0[3]); o.z = pk2(s[4 * 33] * q.g1[0], s[5 * 33] * q.g1[1]); o.w = pk2(s[6 * 33] * q.g1[2], s[7 * 33] * q.g1[3]);
        *(v4u*)(t.WT + (size_t)remap_rt(t.mode, t.n0 + n) * t.K + t.k0 + 8 * c) = o; }
    LDS_WAIT(); asm volatile("" ::: "memory");
}
template <int SET> __device__ __forceinline__ void p0_transposes(const Args& a, LAS unsigned char* lds, int widx, int nw, int wave, int lane) {
    LAS float* scr = (LAS float*)(lds + wave * 16384);
    const int gw = widx * NWAVES + wave, NGW = nw * NWAVES;
    constexpr int I_GU = (D / 64) * (2 * FF / 32), I_D = (FF / 64) * (D / 32), I_IN = (D / 64) * (4096 / 32), I_SQ = (D / 64) * (D / 32), I_KV = (D / 64) * (256 / 32);
    constexpr int NITEMS = SET == 0 ? I_GU + I_D + I_IN + I_SQ : 3 * I_GU + 3 * I_D + 2 * I_SQ + I_KV;
    int it = gw; if (it >= NITEMS) return;
    TItem ta = titem<SET>(a, it), tb = ta; TRegs ra, rb;
    tload(ta, lane, ra);
    for (;;) {
        const int i1 = it + NGW; const bool h1 = i1 < NITEMS;
        if (h1) { tb = titem<SET>(a, i1); tload(tb, lane, rb); }
        tfinish(ta, scr, lane, ra);
        if (!h1) break;
        const int i2 = i1 + NGW; const bool h2 = i2 < NITEMS;
        if (h2) { ta = titem<SET>(a, i2); tload(ta, lane, ra); }
        tfinish(tb, scr, lane, rb);
        if (!h2) break;
        it = i2;
    }
}
__device__ __forceinline__ void p0_prologue(const Args& a, LAS unsigned char* lds, int bid, int G, int wave, int lane) {
    p0_transposes<0>(a, lds, bid, G, wave, lane);
    const int gw = bid * NWAVES + wave, NGW = G * NWAVES;
    unsigned char* ws = a.ws;
    bf16* hb = (bf16*)(ws + WS_HB); float* ssq = (float*)(ws + WS_SSQ);
    for (int m = gw; m < M; m += 2 * NGW) {
        const int m2 = m + NGW;
        const bool has2 = m2 < M;
        const f32x4* xr = (const f32x4*)(a.x + (size_t)m * D) + lane; const f32x4* xr2 = (const f32x4*)(a.x + (size_t)(has2 ? m2 : m) * D) + lane;
        f32x4 v[4], v2[4]; float s = 0.f, s2 = 0.f;
#pragma unroll
        for (int j = 0; j < 4; ++j) { v[j] = xr[64 * j]; v2[j] = xr2[64 * j]; }
#pragma unroll
        for (int j = 0; j < 4; ++j) { s += (v[j].x * v[j].x + v[j].y * v[j].y) + (v[j].z * v[j].z + v[j].w * v[j].w); s2 += (v2[j].x * v2[j].x + v2[j].y * v2[j].y) + (v2[j].z * v2[j].z + v2[j].w * v2[j].w); }
        s = wave_sum(s); s2 = wave_sum(s2);
        unsigned long long* o8 = (unsigned long long*)(hb + (size_t)m * D) + lane;
#pragma unroll
        for (int j = 0; j < 4; ++j) o8[64 * j] = (unsigned long long)pk2(v[j].x, v[j].y) | ((unsigned long long)pk2(v[j].z, v[j].w) << 32);
        if (lane < 16) ssq[(size_t)m * 16 + lane] = lane == 0 ? s : 0.f;
        if (has2) {
            unsigned long long* o82 = (unsigned long long*)(hb + (size_t)m2 * D) + lane;
#pragma unroll
            for (int j = 0; j < 4; ++j) o82[64 * j] = (unsigned long long)pk2(v2[j].x, v2[j].y) | ((unsigned long long)pk2(v2[j].z, v2[j].w) << 32);
            if (lane < 16) ssq[(size_t)m2 * 16 + lane] = lane == 0 ? s2 : 0.f;
        }
    }
    float* lbv = (float*)(ws + WS_MISC); float* rope = (float*)(ws + WS_MISC + 65536);
    for (int i = gw * 64 + lane; i < 1024; i += NGW * 64) { const float l0 = a.hgrn_lb_logits[i], l1 = a.hgrn_lb_logits[1024 + i]; lbv[i] = 1.0f / (1.0f + expf(l1 - l0)); }
    for (int i = gw * 64 + lane; i < 2048 * 8; i += NGW * 64) { const int pos = i >> 3, k = i & 7;
        const float inv_freq = powf(500000.0f, -(float)k * 0.125f); const float ang = (float)pos * inv_freq;
        rope[2 * i] = cosf(ang); rope[2 * i + 1] = sinf(ang); }
}

constexpr int HQE = 0, HKE = 17408, HKDT = 34816, HVT = 53248, HSC = 71680, HBEND = 80896, HCUM = 81408, HNRM = 85504;
constexpr int PQ = 272, PT = 144;
typedef float f32x2 __attribute__((ext_vector_type(2)));
typedef _Float16 h2v __attribute__((ext_vector_type(2)));
__device__ __forceinline__ void hgrn_phase(LAS unsigned char* lds, const bf16* qb, const float* fgt, const bf16* vb, const bf16* gb, bf16* og, const float* onorm_g, int G, int bid, int tid, int w, int lane, unsigned* xbar = nullptr, unsigned xcc_ = 0u, int midc = -1) {
    const int g = lane >> 4, lr = lane & 15;
    const int cp = lane, grp = w;
#define HG_FINALIZE(ROW0) do { \
        _Pragma("unroll") for (int t4 = 0; t4 < 4; ++t4) { const int t = 16 * t4 + lr; const f32x4 na = *(const LAS f32x4*)(lds + HNRM + t * 32), nb = *(const LAS f32x4*)(lds + HNRM + t * 32 + 16); \
            const float tot2 = ((na[0] + na[1]) + (na[2] + na[3])) + ((nb[0] + nb[1]) + (nb[2] + nb[3])); const float r = __builtin_amdgcn_rsqf(tot2 * (1.0f / 128.0f) + EPS); \
            const float g0 = bf2f((unsigned short)(gt[t4].x & 0xffffu)), g1 = bf2f((unsigned short)(gt[t4].x >> 16)), g2 = bf2f((unsigned short)(gt[t4].y & 0xffffu)), g3 = bf2f((unsigned short)(gt[t4].y >> 16)); \
            v2u ov; ov.x = pk2(o[t4][0] * r * gnv[0] * g0, o[t4][1] * r * gnv[1] * g1); ov.y = pk2(o[t4][2] * r * gnv[2] * g2, o[t4][3] * r * gnv[3] * g3); \
            *(v2u*)(og + ((ROW0) + t) * 1024 + colbase + 16 * w + 4 * g) = ov; } } while (0)
    for (int item = bid; item < BATCH * HG_HEADS; item += G) {
        const int b = item >> 3, head = item & 7, colbase = head * 128;
        const size_t rbase = (size_t)b * SEQ;
        f32x4 S[8];
#pragma unroll
        for (int j = 0; j < 8; ++j) S[j] = (f32x4){0.f, 0.f, 0.f, 0.f};
        const f32x4 gnv = *(const f32x4*)(onorm_g + 16 * w + 4 * g);
        f32x2 nf[8]; unsigned nq[8], nv[8];
        { const size_t base = (rbase + 8 * grp) * 1024 + colbase + 2 * cp;
#pragma unroll
          for (int i = 0; i < 8; ++i) { nf[i] = __builtin_convertvector(*(const h2v*)((const _Float16*)fgt + base + (size_t)i * 1024), f32x2); nq[i] = *(const unsigned*)(qb + base + (size_t)i * 1024); nv[i] = *(const unsigned*)(vb + base + (size_t)i * 1024); } }
        f32x4 o[4]; v2u gt[4];
#pragma unroll
        for (int t4 = 0; t4 < 4; ++t4) { o[t4] = (f32x4){0.f, 0.f, 0.f, 0.f}; gt[t4] = (v2u){0u, 0u}; }
        for (int c = 0; c < NCHUNK; ++c) {
            if (c == midc) xcd_local_barrier(xbar, xcc_, 32u);
            const size_t row0 = rbase + c * HG_CHUNK;
            f32x2 P[8]; { float p0 = 1.f, p1 = 1.f;
#pragma unroll
              for (int i = 0; i < 8; ++i) { p0 *= nf[i].x; p1 *= nf[i].y; P[i] = (f32x2){p0, p1}; }
              *(LAS f32x2*)(lds + HCUM + (grp * 128 + 2 * cp) * 4) = (f32x2){p0, p1}; }
            LDS_WAIT(); __builtin_amdgcn_s_barrier(); asm volatile("" ::: "memory");
            float pre0 = 1.f, pre1 = 1.f, tot0 = 1.f, tot1 = 1.f;
#pragma unroll
            for (int gg = 0; gg < 8; ++gg) { const f32x2 t = *(const LAS f32x2*)(lds + HCUM + (gg * 128 + 2 * cp) * 4); if (gg < grp) { pre0 *= t.x; pre1 *= t.y; } tot0 *= t.x; tot1 *= t.y; }
            float kd0[8], kd1[8];
#pragma unroll
            for (int i = 0; i < 8; ++i) {
                const float eb0 = pre0 * P[i].x, eb1 = pre1 * P[i].y, k0 = 1.0f - nf[i].x, k1 = 1.0f - nf[i].y;
                const float q0 = bf2f((unsigned short)(nq[i] & 0xffffu)), q1 = bf2f((unsigned short)(nq[i] >> 16));
                const float ke0 = k0 * __builtin_amdgcn_rcpf(eb0), ke1 = k1 * __builtin_amdgcn_rcpf(eb1);
                const int s = 8 * grp + i;
                *(LAS unsigned*)(lds + HQE + s * PQ + cp * 4) = pk2(q0 * eb0, q1 * eb1);
                *(LAS unsigned*)(lds + HKE + s * PQ + cp * 4) = pk2(ke0, ke1);
                kd0[i] = ke0 * tot0; kd1[i] = ke1 * tot1;
            }
            { v4u a, bq, va, vq;
              a.x = pk2(kd0[0], kd0[1]); a.y = pk2(kd0[2], kd0[3]); a.z = pk2(kd0[4], kd0[5]); a.w = pk2(kd0[6], kd0[7]);
              bq.x = pk2(kd1[0], kd1[1]); bq.y = pk2(kd1[2], kd1[3]); bq.z = pk2(kd1[4], kd1[5]); bq.w = pk2(kd1[6], kd1[7]);
              va.x = (nv[0] & 0xffffu) | (nv[1] << 16); va.y = (nv[2] & 0xffffu) | (nv[3] << 16); va.z = (nv[4] & 0xffffu) | (nv[5] << 16); va.w = (nv[6] & 0xffffu) | (nv[7] << 16);
              vq.x = (nv[0] >> 16) | (nv[1] & 0xffff0000u); vq.y = (nv[2] >> 16) | (nv[3] & 0xffff0000u); vq.z = (nv[4] >> 16) | (nv[5] & 0xffff0000u); vq.w = (nv[6] >> 16) | (nv[7] & 0xffff0000u);
              *(LAS v4u*)(lds + HKDT + (2 * cp) * PT + grp * 16) = a; *(LAS v4u*)(lds + HKDT + (2 * cp + 1) * PT + grp * 16) = bq;
              *(LAS v4u*)(lds + HVT + (2 * cp) * PT + grp * 16) = va; *(LAS v4u*)(lds + HVT + (2 * cp + 1) * PT + grp * 16) = vq; }
            if (grp == 0) *(LAS f32x2*)(lds + HBEND + 2 * cp * 4) = (f32x2){tot0, tot1};
            LDS_WAIT(); __builtin_amdgcn_s_barrier(); asm volatile("" ::: "memory");
            if (c > 0) HG_FINALIZE(row0 - HG_CHUNK);
            __builtin_amdgcn_sched_barrier(0);
            if (c + 1 < NCHUNK) { const size_t base = (row0 + HG_CHUNK + 8 * grp) * 1024 + colbase + 2 * cp;
#pragma unroll
              for (int i = 0; i < 8; ++i) { nf[i] = __builtin_convertvector(*(const h2v*)((const _Float16*)fgt + base + (size_t)i * 1024), f32x2); nq[i] = *(const unsigned*)(qb + base + (size_t)i * 1024); nv[i] = *(const unsigned*)(vb + base + (size_t)i * 1024); } }
#pragma unroll
            for (int t4 = 0; t4 < 4; ++t4) gt[t4] = *(const v2u*)(gb + (row0 + 16 * t4 + lr) * 1024 + colbase + 16 * w + 4 * g);
            __builtin_amdgcn_sched_barrier(0);
            { const int tt = w >> 1; const int st0 = 2 * (w & 1);
              bf16x8 af[4], bfr[2][4];
#pragma unroll
              for (int kk = 0; kk < 4; ++kk) { af[kk] = *(const LAS bf16x8*)(lds + HQE + (16 * tt + lr) * PQ + (32 * kk + 8 * g) * 2);
                  bfr[0][kk] = *(const LAS bf16x8*)(lds + HKE + (16 * st0 + lr) * PQ + (32 * kk + 8 * g) * 2); bfr[1][kk] = *(const LAS bf16x8*)(lds + HKE + (16 * (st0 + 1) + lr) * PQ + (32 * kk + 8 * g) * 2); }
              __builtin_amdgcn_sched_barrier(0);
#pragma unroll
              for (int s2 = 0; s2 < 2; ++s2) { const int st = st0 + s2; f32x4 cacc = (f32x4){0.f, 0.f, 0.f, 0.f};
                if (st <= tt) {
#pragma unroll
                    for (int kk = 0; kk < 4; ++kk) cacc = __builtin_amdgcn_mfma_f32_16x16x32_bf16(af[kk], bfr[s2][kk], cacc, 0, 0, 0);
                    if (st == tt) {
#pragma unroll
                        for (int e = 0; e < 4; ++e) if (lr > 4 * g + e) cacc[e] = 0.f;
                    }
                }
#pragma unroll
                for (int e = 0; e < 4; ++e) *(LAS unsigned short*)(lds + HSC + (16 * tt + 4 * g + e) * PT + (16 * st + lr) * 2) = (unsigned short)f2bf(cacc[e]);
              } }
            __builtin_amdgcn_sched_barrier(0);
#pragma unroll
            for (int t4 = 0; t4 < 4; ++t4) o[t4] = (f32x4){0.f, 0.f, 0.f, 0.f};
            {
                bf16x8 sf[4]; v2u qlo[4][4], qhi[4][4];
#pragma unroll
                for (int t4 = 0; t4 < 4; ++t4)
#pragma unroll
                    for (int kk = 0; kk < 4; ++kk) { qlo[t4][kk] = *(const LAS v2u*)(lds + HQE + (16 * t4 + lr) * PQ + (32 * kk + 4 * g) * 2); qhi[t4][kk] = *(const LAS v2u*)(lds + HQE + (16 * t4 + lr) * PQ + (32 * kk + 16 + 4 * g) * 2); }
#pragma unroll
                for (int kk = 0; kk < 4; ++kk) { v4u p; p.x = pk2(S[2 * kk][0], S[2 * kk][1]); p.y = pk2(S[2 * kk][2], S[2 * kk][3]); p.z = pk2(S[2 * kk + 1][0], S[2 * kk + 1][1]); p.w = pk2(S[2 * kk + 1][2], S[2 * kk + 1][3]);
                    sf[kk] = __builtin_bit_cast(bf16x8, p); }
                __builtin_amdgcn_sched_barrier(0);
#pragma unroll
                for (int kk = 0; kk < 4; ++kk)
#pragma unroll
                    for (int t4 = 0; t4 < 4; ++t4) {
                        v4u q4; q4.x = qlo[t4][kk].x; q4.y = qlo[t4][kk].y; q4.z = qhi[t4][kk].x; q4.w = qhi[t4][kk].y;
                        o[t4] = __builtin_amdgcn_mfma_f32_16x16x32_bf16(sf[kk], __builtin_bit_cast(bf16x8, q4), o[t4], 0, 0, 0);
                    }
            }
            __builtin_amdgcn_sched_barrier(0);
            bf16x8 vf[2];
            {
                bf16x8 kf[8][2]; f32x4 dec[8];
#pragma unroll
                for (int ks = 0; ks < 2; ++ks) vf[ks] = *(const LAS bf16x8*)(lds + HVT + (16 * w + lr) * PT + (32 * ks + 8 * g) * 2);
#pragma unroll
                for (int j = 0; j < 8; ++j) { dec[j] = *(const LAS f32x4*)(lds + HBEND + (16 * j + 4 * g) * 4);
#pragma unroll
                    for (int ks = 0; ks < 2; ++ks) kf[j][ks] = *(const LAS bf16x8*)(lds + HKDT + (16 * j + lr) * PT + (32 * ks + 8 * g) * 2); }
                __builtin_amdgcn_sched_barrier(0);
#pragma unroll
                for (int j = 0; j < 8; ++j) S[j] = S[j] * dec[j];
#pragma unroll
                for (int ks = 0; ks < 2; ++ks)
#pragma unroll
                    for (int j = 0; j < 8; ++j) S[j] = __builtin_amdgcn_mfma_f32_16x16x32_bf16(kf[j][ks], vf[ks], S[j], 0, 0, 0);
            }
            __builtin_amdgcn_sched_barrier(0);
            LDS_WAIT(); __builtin_amdgcn_s_barrier(); asm volatile("" ::: "memory");
            {
                bf16x8 scf[4][2];
#pragma unroll
                for (int t4 = 0; t4 < 4; ++t4)
#pragma unroll
                    for (int ks = 0; ks < 2; ++ks) if (2 * ks <= t4) scf[t4][ks] = *(const LAS bf16x8*)(lds + HSC + (16 * t4 + lr) * PT + (32 * ks + 8 * g) * 2);
                __builtin_amdgcn_sched_barrier(0);
#pragma unroll
                for (int ks = 0; ks < 2; ++ks)
#pragma unroll
                    for (int t4 = 0; t4 < 4; ++t4) if (2 * ks <= t4) o[t4] = __builtin_amdgcn_mfma_f32_16x16x32_bf16(vf[ks], scf[t4][ks], o[t4], 0, 0, 0);
            }
#pragma unroll
            for (int t4 = 0; t4 < 4; ++t4) { float ss = (o[t4][0] * o[t4][0] + o[t4][1] * o[t4][1]) + (o[t4][2] * o[t4][2] + o[t4][3] * o[t4][3]); ss += __shfl_xor(ss, 16); ss += __shfl_xor(ss, 32);
                if (g == 0) *(LAS float*)(lds + HNRM + ((16 * t4 + lr) * 8 + w) * 4) = ss; }
        }
        LDS_WAIT(); __builtin_amdgcn_s_barrier(); asm volatile("" ::: "memory");
        HG_FINALIZE(rbase + (NCHUNK - 1) * HG_CHUNK);
    }
#undef HG_FINALIZE
}

constexpr int AKB = 0, APK = 144, AVT = 36864, APV = 528;
__device__ __forceinline__ void attn_phase(LAS unsigned char* lds, const bf16* qa, const bf16* kb, const bf16* vb, bf16* ao, const float* sinks, int G, int bid, int iend, int tid, int w, int lane) {
    const int h = lane >> 5, tl = lane & 31;
    for (int item = bid; item < iend; item += G) {
        const int b = item >> 5, blk = (item >> 1) & 15, kvh = item & 1;
        __syncthreads();
        { const int r = tid >> 1, hf = tid & 1;
          const int d = tid >> 3, seg = tid & 7;
          v4u kx[4], vx[4];
          const bool lo_ok = blk > 0 || r >= 128;
          if (lo_ok) { const size_t grow = (size_t)b * SEQ + (blk - 1) * WINDOW + r; const v4u* kp = (const v4u*)(kb + grow * 128 + kvh * 64 + hf * 32);
#pragma unroll
              for (int i = 0; i < 4; ++i) kx[i] = kp[i]; }
#pragma unroll
          for (int pb = 0; pb < 2; ++pb) if (blk > 0 || pb == 1) { const v4u* vp = (const v4u*)(vb + ((((size_t)b * NBLK + (blk - 1 + pb)) * ATT_KVH + kvh) * 64 + d) * 128 + seg * 16); vx[2 * pb] = vp[0]; vx[2 * pb + 1] = vp[1]; }
          if (lo_ok) {
#pragma unroll
              for (int i = 0; i < 4; ++i) *(LAS v4u*)(lds + AKB + r * APK + (hf * 32 + 8 * i) * 2) = kx[i]; }
#pragma unroll
          for (int pb = 0; pb < 2; ++pb) if (blk > 0 || pb == 1) { *(LAS v4u*)(lds + AVT + d * APV + (pb * 128 + seg * 16) * 2) = vx[2 * pb]; *(LAS v4u*)(lds + AVT + d * APV + (pb * 128 + seg * 16 + 8) * 2) = vx[2 * pb + 1]; }
        }
        __syncthreads();
        const int head = kvh * 8 + w; const float sink = sinks[head] * 1.4426950408889634f;
        bf16x8 qn[4];
        { const size_t qrow0 = (size_t)b * SEQ + blk * WINDOW + tl;
#pragma unroll
          for (int kk = 0; kk < 4; ++kk) qn[kk] = *(const bf16x8*)(qa + qrow0 * 1024 + head * 64 + 16 * kk + 8 * h); }
#pragma unroll 1
        for (int tq = 0; tq < 4; ++tq) {
            const size_t qrow = (size_t)b * SEQ + blk * WINDOW + 32 * tq + tl;
            bf16x8 qf[4];
#pragma unroll
            for (int kk = 0; kk < 4; ++kk) qf[kk] = qn[kk];
            if (tq < 3) {
#pragma unroll
                for (int kk = 0; kk < 4; ++kk) qn[kk] = *(const bf16x8*)(qa + (qrow + 32) * 1024 + head * 64 + 16 * kk + 8 * h);
            }
            const int jlo = blk == 0 ? 4 : 0;
            f32x16 S[5];
            bf16x8 kfr[2][4];
#pragma unroll
            for (int kk = 0; kk < 4; ++kk) kfr[0][kk] = *(const LAS bf16x8*)(lds + AKB + (32 * tq + tl) * APK + (16 * kk + 8 * h) * 2);
#pragma unroll
            for (int jj = 0; jj < 5; ++jj) {
                if (jj < 4) {
#pragma unroll
                    for (int kk = 0; kk < 4; ++kk) kfr[(jj + 1) & 1][kk] = *(const LAS bf16x8*)(lds + AKB + (32 * (tq + jj + 1) + tl) * APK + (16 * kk + 8 * h) * 2);
                }
                __builtin_amdgcn_sched_barrier(0);
#pragma unroll
                for (int e = 0; e < 16; ++e) S[jj][e] = 0.f;
#pragma unroll
                for (int kk = 0; kk < 4; ++kk) S[jj] = __builtin_amdgcn_mfma_f32_32x32x16_bf16(kfr[jj & 1][kk], qf[kk], S[jj], 0, 0, 0);
                __builtin_amdgcn_sched_barrier(0);
            }
#pragma unroll
            for (int e = 0; e < 16; ++e) { const int sl = (e & 3) + 8 * (e >> 2) + 4 * h; S[0][e] = (sl > tl) ? S[0][e] : -INFINITY; S[4][e] = (sl <= tl) ? S[4][e] : -INFINITY; }
            if (blk == 0) {
#pragma unroll
                for (int jj = 0; jj < 4; ++jj) if (tq + jj < 4) {
#pragma unroll
                    for (int e = 0; e < 16; ++e) S[jj][e] = -INFINITY; }
            }
            float mx = sink;
#pragma unroll
            for (int jj = 0; jj < 5; ++jj)
#pragma unroll
                for (int e = 0; e < 16; e += 2) mx = fmaxf(mx, fmaxf(S[jj][e], S[jj][e + 1]));
            mx = fmaxf(mx, __shfl_xor(mx, 32));
            float sum = 0.f;
#pragma unroll
            for (int jj = 0; jj < 5; ++jj)
#pragma unroll
                for (int e = 0; e < 16; ++e) { S[jj][e] = __builtin_amdgcn_exp2f(S[jj][e] - mx); sum += S[jj][e]; }
            sum += __shfl_xor(sum, 32); sum += __builtin_amdgcn_exp2f(sink - mx);
            const float inv = 1.0f / sum;
            f32x16 O[2];
#pragma unroll
            for (int dt = 0; dt < 2; ++dt)
#pragma unroll
                for (int e = 0; e < 16; ++e) O[dt][e] = 0.f;
            v2u vfr[2][2][2];
#define AT_VLOAD(buf, st) do { const int j_ = tq + ((st) >> 1), a_ = (st) & 1; _Pragma("unroll") for (int dt = 0; dt < 2; ++dt) { \
                vfr[buf][dt][0] = *(const LAS v2u*)(lds + AVT + (32 * dt + tl) * APV + (32 * j_ + 16 * a_ + 4 * h) * 2); vfr[buf][dt][1] = *(const LAS v2u*)(lds + AVT + (32 * dt + tl) * APV + (32 * j_ + 16 * a_ + 8 + 4 * h) * 2); } } while (0)
            AT_VLOAD(0, 0);
#pragma unroll
            for (int st = 0; st < 10; ++st) {
                const int jj = st >> 1, a2 = st & 1;
                if (st < 9) AT_VLOAD((st + 1) & 1, st + 1);
                __builtin_amdgcn_sched_barrier(0);
                if (tq + jj >= jlo) {
                    v4u pp; pp.x = pk2(S[jj][8 * a2 + 0], S[jj][8 * a2 + 1]); pp.y = pk2(S[jj][8 * a2 + 2], S[jj][8 * a2 + 3]); pp.z = pk2(S[jj][8 * a2 + 4], S[jj][8 * a2 + 5]); pp.w = pk2(S[jj][8 * a2 + 6], S[jj][8 * a2 + 7]);
                    const bf16x8 pf = __builtin_bit_cast(bf16x8, pp);
#pragma unroll
                    for (int dt = 0; dt < 2; ++dt) { v4u v4; v4.x = vfr[st & 1][dt][0].x; v4.y = vfr[st & 1][dt][0].y; v4.z = vfr[st & 1][dt][1].x; v4.w = vfr[st & 1][dt][1].y;
                        O[dt] = __builtin_amdgcn_mfma_f32_32x32x16_bf16(__builtin_bit_cast(bf16x8, v4), pf, O[dt], 0, 0, 0); }
                }
                __builtin_amdgcn_sched_barrier(0);
            }
#undef AT_VLOAD
#pragma unroll
            for (int dt = 0; dt < 2; ++dt)
#pragma unroll
                for (int rg = 0; rg < 4; ++rg) { v2u ov; ov.x = pk2(O[dt][4 * rg] * inv, O[dt][4 * rg + 1] * inv); ov.y = pk2(O[dt][4 * rg + 2] * inv, O[dt][4 * rg + 3] * inv);
                    *(v2u*)(ao + qrow * 1024 + head * 64 + 32 * dt + 8 * rg + 4 * h) = ov; }
        }
    }
}

struct GuList {
    int x, base, stride, n, late;
    __device__ __forceinline__ bool next(int i, pg8::Unit& u) const { if (i >= n) return false; const int U = base + stride * i, grp = U / 88, r = U - grp * 88, pml = grp * 4 + (r & 3);
        u.pm = 16 * x + (late ? 4 : 0) + (pml < 4 ? pml : pml + 4); u.pn = r >> 2; return true; }
    __device__ __forceinline__ void a_ready(const pg8::Unit&) const {}
    __device__ __forceinline__ void done(const pg8::Unit&) const {}
};
struct ListOrder {
    int pm0, pn0, pm1, pn1, n;
    __device__ __forceinline__ bool next(int i, pg8::Unit& u) const { if (i >= n) return false; u.pm = i == 0 ? pm0 : pm1; u.pn = i == 0 ? pn0 : pn1; return true; }
    __device__ __forceinline__ void a_ready(const pg8::Unit&) const {}
    __device__ __forceinline__ void done(const pg8::Unit&) const {}
};
constexpr int N_PHASES = 15;
__global__ void __launch_bounds__(NWAVES * 64, 2) yoco_fwd(Args args) {
    extern __shared__ __attribute__((aligned(16))) unsigned char lds_raw[];
    LAS unsigned char* lds = (LAS unsigned char*)lds_raw;
    const int tid = threadIdx.x, lane = tid & 63, wave = __builtin_amdgcn_readfirstlane(tid >> 6);
    const int G = gridDim.x, bid = blockIdx.x;
    unsigned char* ws = args.ws;
    bf16* hb = (bf16*)(ws + WS_HB); float* ssq = (float*)(ws + WS_SSQ); bf16* act = (bf16*)(ws + WS_ACT);
    const float* lbv = (const float*)(ws + WS_MISC); const float* rope = (const float*)(ws + WS_MISC + 65536);
    const int lo = args.ph_lo, hi = args.ph_hi;
    volatile LAS unsigned* bst = (volatile LAS unsigned*)(lds + 131072 + 64);
    if (tid < 4) bst[tid] = 0u;
    __syncthreads();
    XcdBarrier bar; bar.bar = (unsigned*)(ws + WS_BAR); bar.x = 0; bar.st = bst;
    if (hi - lo > 1) { bar.x = xb_xcc_id(); if (tid == 0) bst[2] = xb_add(&bar.bar[XB_XCNT(bar.x)], 1u); }
    __syncthreads();
    const int xcc = (int)bar.x, xrank = (int)bst[2];
    int xl = 0, vc = bid;
#define IN(k) (lo <= (k) && (k) < hi)
    if (lo < 0) cg::this_grid().sync();
#define SEAM(k) do { if (IN(k) && IN((k) + 1)) { if (xl && (k) != 0 && (k) != 2 && (k) != 4) xcd_local_barrier(bar.bar, bar.x, 32u); else xcd_barrier(bar); if (PROBE_DUP == 3) xcd_barrier(bar); } } while (0)
    typedef pg8::StaticOrder SO;
#define GEMM_PHASE(EPI, Aptr, Bptr, NN, KK, Eobj) do { pg8::Gemm g_{(const pg8::bf16_t*)(Aptr), (const pg8::bf16_t*)(Bptr), M, (NN), (KK)}; SO S_; S_.init(M, (NN), G, vc); \
        pg8::gemm_phase<EPI, SO, true, true>(lds, g_, S_, Eobj); } while (0)

    if (IN(0)) { if (PROBE_DUP == 1) { p0_prologue(args, lds, bid, G, wave, lane); __syncthreads(); } p0_prologue(args, lds, bid, G, wave, lane); } SEAM(0);
    if (lo == 0 && hi == N_PHASES) {
        if (tid == 0) { unsigned ok = (G == 256) ? 1u : 0u;
            for (unsigned j = 0; j < 16; ++j) { const unsigned cnt = xb_ld(&bar.bar[XB_XCNT(j)]); if (cnt != (j < 8u ? 32u : 0u)) ok = 0u; }
            bst[3] = ok; }
        __syncthreads();
        xl = (int)bst[3];
        if (xl) vc = xrank * 8 + xcc;
    }
    if (IN(1)) { pg8::EpiSwiGLU E{act, ssq}; GEMM_PHASE(pg8::EpiSwiGLU, hb, ws + WS_WGU + 0 * SZ_WGU, 2 * FF, D, E); if (PROBE_DUP == 6) { __syncthreads(); GEMM_PHASE(pg8::EpiSwiGLU, hb, ws + WS_WGU + 0 * SZ_WGU, 2 * FF, D, E); } } SEAM(1);
    if (IN(2)) { if (PROBE_DUP == 7) { pg8::EpiResid<false> E0{(bf16*)(ws + WS_R + 176 * MiB), (float*)(ws + WS_R + 240 * MiB), args.out, 0.5f}; GEMM_PHASE(pg8::EpiResid<false>, act, ws + WS_WD + 0 * SZ_WD, D, FF, E0); __syncthreads(); }
                 pg8::EpiResid<false> E{hb, ssq, args.out, 0.5f}; GEMM_PHASE(pg8::EpiResid<false>, act, ws + WS_WD + 0 * SZ_WD, D, FF, E); } SEAM(2);
    if (IN(3)) { pg8::EpiHgrnIn E{(bf16*)(ws + WS_HQ), (float*)(ws + WS_HLOGF), (long)((WS_HV - WS_HQ) / 2), (long)((WS_HG - WS_HQ) / 2), lbv, ssq}; GEMM_PHASE(pg8::EpiHgrnIn, hb, ws + WS_WIN, 4096, D, E); if (PROBE_DUP == 9) { __syncthreads(); GEMM_PHASE(pg8::EpiHgrnIn, hb, ws + WS_WIN, 4096, D, E); } } SEAM(3);
    if (IN(4)) { if (PROBE_DUP == 2) { hgrn_phase(lds, (const bf16*)(ws + WS_HQ), (const float*)(ws + WS_HLOGF), (const bf16*)(ws + WS_HV), (const bf16*)(ws + WS_HG), (bf16*)(ws + WS_KB), args.hgrn_onorm_g, G, bid, tid, wave, lane); __syncthreads(); }
                 hgrn_phase(lds, (const bf16*)(ws + WS_HQ), (const float*)(ws + WS_HLOGF), (const bf16*)(ws + WS_HV), (const bf16*)(ws + WS_HG), (bf16*)(ws + WS_HG), args.hgrn_onorm_g, xl ? BATCH * HG_HEADS : G, xl ? (xrank < 16 ? (2 * xcc + (xrank >> 3)) * 8 + (xrank & 7) : BATCH * HG_HEADS) : bid, tid, wave, lane, bar.bar, bar.x, xl ? 17 : -1);
                 __syncthreads();
                 if (xl) { if (xrank >= 16) {
                         p0_transposes<1>(args, lds, (xrank - 16) * 8 + xcc, 128, wave, lane);
                         xcd_local_barrier(bar.bar, bar.x, 32u);
                         __syncthreads();
                         const int e0 = xrank - 16, e1 = e0 + 16; const int pl0 = e0 >> 2, pl1 = e1 >> 2;
                         ListOrder LS{16 * xcc + (pl0 < 4 ? pl0 : pl0 + 4), e0 & 3, 16 * xcc + (pl1 < 4 ? pl1 : pl1 + 4), e1 & 3, 2};
                         pg8::Gemm g_{(const pg8::bf16_t*)(ws + WS_HG), (const pg8::bf16_t*)(ws + WS_WHO), M, D, D}; pg8::EpiResid<false> E5{hb, ssq, args.out, 1.0f};
                         pg8::gemm_phase<pg8::EpiResid<false>, ListOrder, true, true>(lds, g_, LS, E5); } }
                 else if (G > BATCH * HG_HEADS) { if (bid >= BATCH * HG_HEADS) p0_transposes<1>(args, lds, bid - BATCH * HG_HEADS, G - BATCH * HG_HEADS, wave, lane); } else p0_transposes<1>(args, lds, bid, G, wave, lane); } SEAM(4);
    if (xl) {
        pg8::EpiResid<false> E5{hb, ssq, args.out, 1.0f}; pg8::EpiSwiGLU E6{act, ssq};
        pg8::Gemm g5{(const pg8::bf16_t*)(ws + WS_HG), (const pg8::bf16_t*)(ws + WS_WHO), M, D, D};
        pg8::Gemm g6{(const pg8::bf16_t*)hb, (const pg8::bf16_t*)(ws + WS_WGU + 1 * SZ_WGU), M, 2 * FF, D};
        unsigned* dep = bar.bar + XL_DEP(xcc);
        if (xrank >= 16) {
            const int e0 = xrank - 16, e1 = e0 + 16, pl0 = e0 >> 2, pl1 = e1 >> 2;
            ListOrder LS{16 * xcc + 4 + (pl0 < 4 ? pl0 : pl0 + 4), e0 & 3, 16 * xcc + 4 + (pl1 < 4 ? pl1 : pl1 + 4), e1 & 3, 2};
            pg8::gemm_phase<pg8::EpiResid<false>, ListOrder, true, true>(lds, g5, LS, E5);
            xl_signal(dep);
            xl_wait(dep, 16u, bar.bar);
            GuList S6{xcc, xrank - 16, 16, 10, 1};
            pg8::gemm_phase<pg8::EpiSwiGLU, GuList, true, true>(lds, g6, S6, E6);
        } else {
            GuList S6{xcc, xrank, 16, 11, 0};
            pg8::gemm_phase<pg8::EpiSwiGLU, GuList, true, true>(lds, g6, S6, E6);
            xl_wait(dep, 16u, bar.bar);
            GuList S7{xcc, 160 + xrank, 16, 1, 1};
            pg8::gemm_phase<pg8::EpiSwiGLU, GuList, true, true>(lds, g6, S7, E6);
        }
    } else {
    if (IN(5)) { pg8::EpiResid<false> E{hb, ssq, args.out, 1.0f}; GEMM_PHASE(pg8::EpiResid<false>, ws + WS_HG, ws + WS_WHO, D, D, E); } SEAM(5);
    if (IN(6)) { pg8::EpiSwiGLU E{act, ssq}; GEMM_PHASE(pg8::EpiSwiGLU, hb, ws + WS_WGU + 1 * SZ_WGU, 2 * FF, D, E); }
    }
    SEAM(6);
    if (IN(7)) { pg8::EpiResid<false> E{hb, ssq, args.out, 0.5f}; GEMM_PHASE(pg8::EpiResid<false>, act, ws + WS_WD + 1 * SZ_WD, D, FF, E); } SEAM(7);
    if (IN(8)) { pg8::EpiHead<false> E{(bf16*)(ws + WS_KB), (long)((WS_VB - WS_KB) / 2), args.k_norm_g, rope, ssq, 1.0f}; GEMM_PHASE(pg8::EpiHead<false>, hb, ws + WS_WKV, 256, D, E); if (PROBE_DUP == 8) { __syncthreads(); GEMM_PHASE(pg8::EpiHead<false>, hb, ws + WS_WKV, 256, D, E); }
                 __syncthreads();
                 pg8::EpiSwiGLU E2{act, ssq}; GEMM_PHASE(pg8::EpiSwiGLU, hb, ws + WS_WGU + 2 * SZ_WGU, 2 * FF, D, E2); } SEAM(8);
    if (IN(9)) { pg8::EpiResid<false> E{hb, ssq, args.out, 0.5f}; GEMM_PHASE(pg8::EpiResid<false>, act, ws + WS_WD + 2 * SZ_WD, D, FF, E); } SEAM(9);
    if (IN(10)) { pg8::EpiHead<true> E{(bf16*)(ws + WS_QA), 0l, args.q_norm_g, rope, ssq, 0.125f * 1.4426950408889634f}; GEMM_PHASE(pg8::EpiHead<true>, hb, ws + WS_WQ, D, D, E); } SEAM(10);
    if (IN(11)) { if (PROBE_DUP == 4) { attn_phase(lds, (const bf16*)(ws + WS_QA), (const bf16*)(ws + WS_KB), (const bf16*)(ws + WS_VB), (bf16*)(ws + WS_R + 128 * MiB), args.attn_sinks, G, bid, BATCH * NBLK * ATT_KVH, tid, wave, lane); __syncthreads(); }
                  attn_phase(lds, (const bf16*)(ws + WS_QA), (const bf16*)(ws + WS_KB), (const bf16*)(ws + WS_VB), (bf16*)(ws + WS_QA), args.attn_sinks, xl ? 32 : G, xl ? 64 * xcc + xrank : bid, xl ? 64 * xcc + 64 : BATCH * NBLK * ATT_KVH, tid, wave, lane); } SEAM(11);
    if (IN(12)) { if (PROBE_DUP == 10) { pg8::EpiResid<false> E0{(bf16*)(ws + WS_R + 176 * MiB), (float*)(ws + WS_R + 240 * MiB), args.out, 1.0f}; GEMM_PHASE(pg8::EpiResid<false>, ws + WS_QA, ws + WS_WAO, D, D, E0); __syncthreads(); }
                  pg8::EpiResid<false> E{hb, ssq, args.out, 1.0f}; GEMM_PHASE(pg8::EpiResid<false>, ws + WS_QA, ws + WS_WAO, D, D, E); } SEAM(12);
    if (IN(13)) { pg8::EpiSwiGLU E{act, ssq}; GEMM_PHASE(pg8::EpiSwiGLU, hb, ws + WS_WGU + 3 * SZ_WGU, 2 * FF, D, E); } SEAM(13);
    if (IN(14)) { pg8::EpiResid<true> E{hb, ssq, args.out, 0.5f}; GEMM_PHASE(pg8::EpiResid<true>, act, ws + WS_WD + 3 * SZ_WD, D, FF, E); }
#undef IN
#undef SEAM
#undef GEMM_PHASE
}

extern "C" void kernel_launch(void* const* d_in, const int* in_sizes, int n_in, void* d_out, int out_size, void* d_ws, size_t ws_size, hipStream_t stream) {
    static int grid = 0;
    if (grid == 0) {
        if (n_in != 16 || in_sizes[0] != M * D || out_size != M * D || ws_size < WS_END) { fprintf(stderr, "kernel_launch: unexpected problem (n_in %d, in0 %d, out %d, ws %zu, need %zu)\n", n_in, n_in > 0 ? in_sizes[0] : -1, out_size, ws_size, (size_t)WS_END); grid = -1; return; }
        int dev = 0, cus = 0, per_cu = 0;
        if (hipGetDevice(&dev) != hipSuccess || hipDeviceGetAttribute(&cus, hipDeviceAttributeMultiprocessorCount, dev) != hipSuccess) { grid = -1; return; }
        if (hipFuncSetAttribute((const void*)yoco_fwd, hipFuncAttributeMaxDynamicSharedMemorySize, LDS_BYTES) != hipSuccess) { fprintf(stderr, "kernel_launch: hipFuncSetAttribute failed\n"); grid = -1; return; }
        if (hipOccupancyMaxActiveBlocksPerMultiprocessor(&per_cu, (const void*)yoco_fwd, NWAVES * 64, LDS_BYTES) != hipSuccess || per_cu < 1) { fprintf(stderr, "kernel_launch: occupancy query says %d\n", per_cu); per_cu = 1; }
        (void)hipGetLastError();
        grid = cus;
    }
    if (grid < 0) return;
    Args a{};
    a.x = (const float*)d_in[0]; a.ffn_norm_g = (const float*)d_in[1]; a.ffn_w_gate_up = (const float*)d_in[2]; a.ffn_w_down = (const float*)d_in[3]; a.mix_norm_g = (const float*)d_in[4];
    a.hgrn_w_in = (const float*)d_in[5]; a.hgrn_lb_logits = (const float*)d_in[6]; a.hgrn_onorm_g = (const float*)d_in[7]; a.hgrn_w_out = (const float*)d_in[8]; a.kv_norm_g = (const float*)d_in[9];
    a.kv_w = (const float*)d_in[10]; a.k_norm_g = (const float*)d_in[11]; a.attn_w_q = (const float*)d_in[12]; a.q_norm_g = (const float*)d_in[13]; a.attn_sinks = (const float*)d_in[14]; a.attn_w_out = (const float*)d_in[15];
    a.out = (float*)d_out; a.ws = (unsigned char*)d_ws;
#if MK_ONE_LAUNCH
    if (hipMemsetAsync((char*)d_ws + WS_BAR, 0, BAR_BYTES, stream) != hipSuccess) { fprintf(stderr, "kernel_launch: memset failed\n"); return; }
    a.ph_lo = 0; a.ph_hi = N_PHASES;
    void* kargs[] = {&a};
    hipError_t e = hipLaunchCooperativeKernel((const void*)yoco_fwd, dim3(grid), dim3(NWAVES * 64), kargs, LDS_BYTES, stream);
    if (e != hipSuccess) fprintf(stderr, "kernel_launch: cooperative launch failed: %s (grid %d)\n", hipGetErrorString(e), grid);
#else
    for (int p = 0; p < N_PHASES; ++p) { a.ph_lo = p; a.ph_hi = p + 1; hipLaunchKernelGGL(yoco_fwd, dim3(grid), dim3(NWAVES * 64), LDS_BYTES, stream, a); }
#endif
}
```
